# Optimizing an MI355X kernel written in HIP

```python
import math
import jax, jax.numpy as jnp
from jax import lax
import numpy as np

D_MODEL = 1024
BATCH = 8
SEQ = 2048
DEPTH = 2

MIX_WIDTH = D_MODEL
ATTN_WIDTH = MIX_WIDTH // 2
POOL_WIDTH = MIX_WIDTH - ATTN_WIDTH
N_DIFF_HEADS = 4
DIFF_HEAD_DIM = ATTN_WIDTH // N_DIFF_HEADS // 2
DIFF_V_DIM = 2 * DIFF_HEAD_DIM
POOL_WINDOWS = (2, 4, 8, 16)
N_POOL_GROUPS = len(POOL_WINDOWS)
POOL_GROUP_DIM = POOL_WIDTH // N_POOL_GROUPS
IN_WIDTH = 3 * ATTN_WIDTH + POOL_WIDTH
FF_MULTIPLE = 256
D_FF = ((8 * D_MODEL + 3 * FF_MULTIPLE - 1) // (3 * FF_MULTIPLE)) * FF_MULTIPLE
Q_BLOCK = 128
NORM_EPS = 1e-5

kernel_name = "hymba_diffattn_multiscale_pool_block"


def rms_norm(x, g):
    xf = x.astype(jnp.float32)
    y = xf * lax.rsqrt(jnp.mean(xf * xf, axis=-1, keepdims=True) + NORM_EPS)
    return (y * g.astype(jnp.float32)).astype(x.dtype)


def lambda_init(layer):
    return 0.8 - 0.6 * math.exp(-0.3 * layer)


def diff_attention(q, k, v, lam):
    seq = q.shape[1]
    scale = DIFF_HEAD_DIM ** -0.5
    q1 = jnp.transpose(q[:, :, :, 0, :], (0, 2, 1, 3)) * scale
    q2 = jnp.transpose(q[:, :, :, 1, :], (0, 2, 1, 3)) * scale
    k1 = jnp.transpose(k[:, :, :, 0, :], (0, 2, 1, 3))
    k2 = jnp.transpose(k[:, :, :, 1, :], (0, 2, 1, 3))
    vh = jnp.transpose(v, (0, 2, 1, 3)).astype(jnp.float32)
    outs = []
    for blk in range(seq // Q_BLOCK):
        start = blk * Q_BLOCK
        end = start + Q_BLOCK
        mask = jnp.arange(end)[None, :] <= (start + jnp.arange(Q_BLOCK))[:, None]
        s1 = jnp.einsum('bhqd,bhkd->bhqk', q1[:, :, start:end], k1[:, :, :end]).astype(jnp.float32)
        s2 = jnp.einsum('bhqd,bhkd->bhqk', q2[:, :, start:end], k2[:, :, :end]).astype(jnp.float32)
        s1 = jnp.where(mask, s1, -jnp.inf)
        s2 = jnp.where(mask, s2, -jnp.inf)
        attn = jax.nn.softmax(s1, axis=-1) - lam * jax.nn.softmax(s2, axis=-1)
        outs.append(jnp.einsum('bhqk,bhkv->bhqv', attn, vh[:, :, :end]))
    o = jnp.concatenate(outs, axis=2)
    return jnp.transpose(o, (0, 2, 1, 3)).astype(v.dtype)


def causal_multiscale_pool(u, pool_w, pool_scale):
    seq = u.shape[1]
    pos_count = (jnp.arange(seq) + 1)[None, :, None]
    ys = []
    for g, w in enumerate(POOL_WINDOWS):
        ug = u[..., g * POOL_GROUP_DIM:(g + 1) * POOL_GROUP_DIM].astype(jnp.float32)
        cs = jnp.cumsum(ug, axis=1)
        prev = jnp.pad(cs, ((0, 0), (w, 0), (0, 0)))[:, :seq]
        count = jnp.minimum(pos_count, w).astype(jnp.float32)
        resid = (cs - prev) / count - ug
        ys.append(jnp.einsum('bsc,cd->bsd', resid, pool_w[g].astype(jnp.float32)))
    y = jnp.concatenate(ys, axis=-1) * pool_scale.astype(jnp.float32)
    return y.astype(u.dtype)


def setup_inputs(seed: int = 0) -> dict:
    key = jax.random.key(seed)
    ks = jax.random.split(key, 14)
    f32 = jnp.float32
    def nrm(k, shape, fan_in):
        return jax.random.normal(k, shape, f32) * (fan_in ** -0.5)
    def gain(k, shape):
        return 1.0 + 0.02 * jax.random.normal(k, shape, f32)
    return {
        "x": jax.random.normal(ks[0], (BATCH, SEQ, D_MODEL), f32),
        "norm1_g": gain(ks[1], (DEPTH, D_MODEL)),
        "w_in": nrm(ks[2], (DEPTH, D_MODEL, IN_WIDTH), D_MODEL),
        "lam_qk": 0.1 * jax.random.normal(ks[3], (DEPTH, 4, DIFF_HEAD_DIM), f32),
        "subln_g": gain(ks[4], (DEPTH, DIFF_V_DIM)),
        "pool_w": nrm(ks[5], (DEPTH, N_POOL_GROUPS, POOL_GROUP_DIM, POOL_GROUP_DIM), POOL_GROUP_DIM),
        "pool_scale": gain(ks[6], (DEPTH, POOL_WIDTH)),
        "w_out": nrm(ks[7], (DEPTH, MIX_WIDTH, D_MODEL), MIX_WIDTH),
        "norm2_g": gain(ks[8], (DEPTH, D_MODEL)),
        "w_gate": nrm(ks[9], (DEPTH, D_MODEL, D_FF), D_MODEL),
        "w_up": nrm(ks[10], (DEPTH, D_MODEL, D_FF), D_MODEL),
        "w_down": nrm(ks[11], (DEPTH, D_FF, D_MODEL), D_FF),
        "final_g": gain(ks[12], (D_MODEL,)),
    }


def reference(x, norm1_g, w_in, lam_qk, subln_g, pool_w, pool_scale, w_out,
              norm2_g, w_gate, w_up, w_down, final_g):
    bsz, seq, _ = x.shape
    for layer in range(DEPTH):
        lam0 = lambda_init(layer)
        h = rms_norm(x, norm1_g[layer])
        proj = jnp.einsum('bsd,de->bse', h, w_in[layer])
        q = proj[..., :ATTN_WIDTH].reshape(bsz, seq, N_DIFF_HEADS, 2, DIFF_HEAD_DIM)
        k = proj[..., ATTN_WIDTH:2 * ATTN_WIDTH].reshape(bsz, seq, N_DIFF_HEADS, 2, DIFF_HEAD_DIM)
        v = proj[..., 2 * ATTN_WIDTH:3 * ATTN_WIDTH].reshape(bsz, seq, N_DIFF_HEADS, DIFF_V_DIM)
        u = proj[..., 3 * ATTN_WIDTH:]
        lq = lam_qk[layer].astype(jnp.float32)
        lam = (jnp.exp(jnp.sum(lq[0] * lq[1])) - jnp.exp(jnp.sum(lq[2] * lq[3])) + lam0)
        a = diff_attention(q, k, v, lam)
        a = (rms_norm(a, subln_g[layer]) * (1.0 - lam0)).reshape(bsz, seq, ATTN_WIDTH)
        p = causal_multiscale_pool(u, pool_w[layer], pool_scale[layer])
        mixed = jnp.concatenate([a, p], axis=-1)
        x = x + jnp.einsum('bse,ed->bsd', mixed, w_out[layer])
        h2 = rms_norm(x, norm2_g[layer])
        gate = jnp.einsum('bsd,df->bsf', h2, w_gate[layer])
        up = jnp.einsum('bsd,df->bsf', h2, w_up[layer])
        x = x + jnp.einsum('bsf,fd->bsd', jax.nn.silu(gate) * up, w_down[layer])
    return rms_norm(x, final_g)
```

```cpp
#include <hip/hip_runtime.h>
#include <cstdint>
#include <cstdio>
#include <cmath>

constexpr int BATCH = 8, SEQ = 2048, DM = 1024, DEPTH = 2, M = BATCH * SEQ;
constexpr int NH = 4, DV = 128, ATTW = 512, INW = 2048, DFF = 2816, NGU = 2 * DFF;
constexpr float EPS = 1e-5f;
constexpr float C2 = 0.125f * 1.4426950408889634f;

typedef unsigned short bf16;
typedef short bf16x8 __attribute__((ext_vector_type(8)));
typedef float f32x4 __attribute__((ext_vector_type(4)));

__device__ __forceinline__ unsigned f2bf(float f) { unsigned u = __builtin_bit_cast(unsigned, f); return (u + 0x7fffu + ((u >> 16) & 1u)) >> 16; }
__device__ __forceinline__ unsigned pk2(float lo, float hi) { return f2bf(lo) | (f2bf(hi) << 16); }
__device__ __forceinline__ float bf2f(bf16 b) { return __builtin_bit_cast(float, (unsigned)b << 16); }

constexpr size_t MiB = 1u << 20;
constexpr size_t WS_CTL = 0;
constexpr size_t WS_W1 = 1 * MiB;
constexpr size_t WS_WO = 9 * MiB;
constexpr size_t WS_WGU = 13 * MiB;
constexpr size_t WS_WD = 35 * MiB;
constexpr size_t WS_SSQ = 46 * MiB;
constexpr size_t WS_LAM = 47 * MiB;
constexpr size_t WS_XB = 48 * MiB;
constexpr size_t WS_PROJ = 80 * MiB;
constexpr size_t WS_MIX = 144 * MiB;
constexpr size_t WS_H = 80 * MiB;
constexpr size_t WS_END = 176 * MiB;
static_assert(WS_H + (size_t)M * DFF * 2 <= WS_END && WS_MIX + (size_t)M * DM * 2 <= WS_END, "ws map");

__global__ void __launch_bounds__(256) k_transpose(const float* __restrict__ W, int K, int N, bf16* __restrict__ WT, int ldk, int row_off, int mode) {
    __shared__ float scr_all[4][64 * 33];
    const int wave = threadIdx.x >> 6, lane = threadIdx.x & 63;
    float* scr = scr_all[wave];
    const int nblk = N / 32, nitems = (K / 64) * nblk;
    for (int item = blockIdx.x * 4 + wave; item < nitems; item += gridDim.x * 4) {
        const int kb = item / nblk, nb = item % nblk, k0 = 64 * kb, n0 = 32 * nb;
        for (int i = 0; i < 32; ++i) { const int kk = 2 * i + (lane >> 5); scr[kk * 33 + (lane & 31)] = W[(size_t)(k0 + kk) * N + n0 + (lane & 31)]; }
        __builtin_amdgcn_wave_barrier(); asm volatile("s_waitcnt lgkmcnt(0)" ::: "memory");
        const int c = lane & 7;
        const int rbase = (mode == 1) ? (256 * (n0 / 128) + (n0 % 128) + row_off) : (row_off + n0);
        for (int j = 0; j < 4; ++j) { const int n = (lane >> 3) + 8 * j; const float* s = scr + (8 * c) * 33 + n;
            uint4 o; o.x = pk2(s[0 * 33], s[1 * 33]); o.y = pk2(s[2 * 33], s[3 * 33]); o.z = pk2(s[4 * 33], s[5 * 33]); o.w = pk2(s[6 * 33], s[7 * 33]);
            *(uint4*)(WT + (size_t)(rbase + n) * ldk + k0 + 8 * c) = o; }
        asm volatile("s_waitcnt lgkmcnt(0)" ::: "memory"); __builtin_amdgcn_wave_barrier();
    }
}
__global__ void __launch_bounds__(256) k_fold_pool(const float* __restrict__ pool_w, const float* __restrict__ scale, const float* __restrict__ w_out, bf16* __restrict__ WoT) {
    const int idx = blockIdx.x * 256 + threadIdx.x;
    const int n = idx & 1023, gc = idx >> 10, g = gc >> 7, c = gc & 127;
    const float* pw = pool_w + ((size_t)g * 128 + c) * 128; const float* sc = scale + 128 * g; const float* wo = w_out + (size_t)(512 + 128 * g) * DM + n;
    float acc = 0.f;
    for (int d = 0; d < 128; ++d) acc = fmaf(pw[d] * sc[d], wo[(size_t)d * DM], acc);
    WoT[(size_t)n * DM + 512 + gc] = (bf16)f2bf(acc);
}
__global__ void k_lambda(const float* __restrict__ lam_qk, float* __restrict__ lam_out, float lam0_0, float lam0_1) {
    const int l = threadIdx.x; if (l >= DEPTH) return;
    const float* q = lam_qk + l * 256; float s1 = 0.f, s2 = 0.f;
    for (int i = 0; i < 64; ++i) { s1 += q[i] * q[64 + i]; s2 += q[128 + i] * q[192 + i]; }
    lam_out[l] = expf(s1) - expf(s2) + (l == 0 ? lam0_0 : lam0_1);
}
__global__ void __launch_bounds__(256) k_prep_x(const float* __restrict__ x, const float* __restrict__ g, bf16* __restrict__ XB, float* __restrict__ SSQ) {
    const int row = blockIdx.x * 4 + (threadIdx.x >> 6), lane = threadIdx.x & 63;
    const f32x4* xr = (const f32x4*)(x + (size_t)row * DM) + lane; const f32x4* gr = (const f32x4*)g + lane;
    float s = 0.f;
    for (int j = 0; j < 4; ++j) { const f32x4 v = xr[64 * j], gg = gr[64 * j]; s += (v.x * v.x + v.y * v.y) + (v.z * v.z + v.w * v.w);
        uint2 o; o.x = pk2(v.x * gg.x, v.y * gg.y); o.y = pk2(v.z * gg.z, v.w * gg.w); *((uint2*)(XB + (size_t)row * DM) + lane + 64 * j) = o; }
    for (int o = 1; o < 64; o <<= 1) s += __shfl_xor(s, o);
    if (lane == 0) *(f32x4*)(SSQ + (size_t)row * 4) = (f32x4){s, 0.f, 0.f, 0.f};
}
__device__ __forceinline__ float row_rstd(const float* SSQ, int row) { const f32x4 s = *(const f32x4*)(SSQ + (size_t)row * 4); return 1.0f / sqrtf(((s.x + s.y) + (s.z + s.w)) * (1.0f / DM) + EPS); }

enum { EPI_PROJ = 0, EPI_RES = 1, EPI_SWIGLU = 2 };
struct EpiArgs { bf16* outb; float* outf; const float* base; const float* SSQ; int ldc; int pad; };
template <int EPI, int NB> __global__ void __launch_bounds__(256) k_gemm(const bf16* __restrict__ A, const bf16* __restrict__ Bt, int K, EpiArgs e) {
    const int lane = threadIdx.x & 63, w = threadIdx.x >> 6, fr = lane & 15, fq = lane >> 4;
    const int m0 = blockIdx.y * 128 + 64 * (w >> 1), n0 = blockIdx.x * (NB * 128) + 64 * (w & 1);
    f32x4 acc[NB][4][4];
    for (int g = 0; g < NB; ++g) for (int i = 0; i < 4; ++i) for (int j = 0; j < 4; ++j) acc[g][i][j] = (f32x4){0.f, 0.f, 0.f, 0.f};
    const bf16* ap = A + (size_t)(m0 + fr) * K + 8 * fq; const bf16* bp = Bt + (size_t)(n0 + fr) * K + 8 * fq;
    for (int k0 = 0; k0 < K; k0 += 32) {
        bf16x8 af[4], bfr[NB][4];
#pragma unroll
        for (int i = 0; i < 4; ++i) af[i] = *(const bf16x8*)(ap + (size_t)(16 * i) * K + k0);
#pragma unroll
        for (int g = 0; g < NB; ++g)
#pragma unroll
            for (int j = 0; j < 4; ++j) bfr[g][j] = *(const bf16x8*)(bp + (size_t)(128 * g + 16 * j) * K + k0);
#pragma unroll
        for (int g = 0; g < NB; ++g)
#pragma unroll
            for (int i = 0; i < 4; ++i)
#pragma unroll
                for (int j = 0; j < 4; ++j) acc[g][i][j] = __builtin_amdgcn_mfma_f32_16x16x32_bf16(bfr[g][j], af[i], acc[g][i][j], 0, 0, 0);
    }
#pragma unroll
    for (int i = 0; i < 4; ++i) {
        const int row = m0 + 16 * i + fr;
        if (EPI == EPI_PROJ) {
            const float r = row_rstd(e.SSQ, row);
#pragma unroll
            for (int j = 0; j < 4; ++j) { const int col = n0 + 16 * j + 4 * fq; const float s = (col < ATTW) ? r * C2 : r; const f32x4 v = acc[0][i][j] * s;
                uint2 o; o.x = pk2(v.x, v.y); o.y = pk2(v.z, v.w); *(uint2*)(e.outb + (size_t)row * e.ldc + col) = o; }
        } else if (EPI == EPI_RES) {
#pragma unroll
            for (int j = 0; j < 4; ++j) { const int col = n0 + 16 * j + 4 * fq; const f32x4 b = *(const f32x4*)(e.base + (size_t)row * e.ldc + col);
                *(f32x4*)(e.outf + (size_t)row * e.ldc + col) = b + acc[0][i][j]; }
        } else {
            const float r = row_rstd(e.SSQ, row);
#pragma unroll
            for (int j = 0; j < 4; ++j) { const int col = blockIdx.x * 128 + 64 * (w & 1) + 16 * j + 4 * fq;
                const f32x4 gt = acc[0][i][j] * r, up = acc[NB - 1][i][j] * r; f32x4 h;
                for (int q = 0; q < 4; ++q) h[q] = gt[q] / (1.0f + __expf(-gt[q])) * up[q];
                uint2 o; o.x = pk2(h.x, h.y); o.y = pk2(h.z, h.w); *(uint2*)(e.outb + (size_t)row * e.ldc + col) = o; }
        }
    }
}

__global__ void __launch_bounds__(128) k_attn_naive(const bf16* __restrict__ PROJ, bf16* __restrict__ MIX, const float* __restrict__ lamp, int layer, const float* __restrict__ subln_g, float one_minus_lam0) {
    __shared__ float s1[SEQ], s2[SEQ], qv[128], red[8];
    const int tid = threadIdx.x, qpos = blockIdx.x, h = blockIdx.y, b = blockIdx.z;
    const size_t row = (size_t)b * SEQ + qpos;
    qv[tid] = bf2f(PROJ[row * INW + h * 128 + tid]);
    __syncthreads();
    float m1 = -INFINITY, m2 = -INFINITY;
    for (int j = tid; j <= qpos; j += 128) {
        const bf16* kr = PROJ + ((size_t)b * SEQ + j) * INW + ATTW + h * 128; float a1 = 0.f, a2 = 0.f;
        for (int d = 0; d < 64; d += 8) { const uint4 k1 = *(const uint4*)(kr + d), k2 = *(const uint4*)(kr + 64 + d);
            const unsigned u1[4] = {k1.x, k1.y, k1.z, k1.w}, u2[4] = {k2.x, k2.y, k2.z, k2.w};
            for (int t = 0; t < 4; ++t) { a1 += qv[d + 2 * t] * __builtin_bit_cast(float, u1[t] << 16) + qv[d + 2 * t + 1] * __builtin_bit_cast(float, u1[t] & 0xffff0000u);
                                          a2 += qv[64 + d + 2 * t] * __builtin_bit_cast(float, u2[t] << 16) + qv[64 + d + 2 * t + 1] * __builtin_bit_cast(float, u2[t] & 0xffff0000u); } }
        s1[j] = a1; s2[j] = a2; m1 = fmaxf(m1, a1); m2 = fmaxf(m2, a2);
    }
    for (int o = 1; o < 64; o <<= 1) { m1 = fmaxf(m1, __shfl_xor(m1, o)); m2 = fmaxf(m2, __shfl_xor(m2, o)); }
    if ((tid & 63) == 0) { red[tid >> 6] = m1; red[2 + (tid >> 6)] = m2; }
    __syncthreads();
    m1 = fmaxf(red[0], red[1]); m2 = fmaxf(red[2], red[3]);
    float l1 = 0.f, l2 = 0.f;
    for (int j = tid; j <= qpos; j += 128) { const float p1 = exp2f(s1[j] - m1), p2 = exp2f(s2[j] - m2); s1[j] = p1; s2[j] = p2; l1 += p1; l2 += p2; }
    for (int o = 1; o < 64; o <<= 1) { l1 += __shfl_xor(l1, o); l2 += __shfl_xor(l2, o); }
    if ((tid & 63) == 0) { red[4 + (tid >> 6)] = l1; red[6 + (tid >> 6)] = l2; }
    __syncthreads();
    l1 = red[4] + red[5]; l2 = red[6] + red[7];
    float o1 = 0.f, o2 = 0.f;
    const bf16* vp = PROJ + (size_t)b * SEQ * INW + 2 * ATTW + h * 128 + tid;
    for (int j = 0; j <= qpos; ++j) { const float v = bf2f(vp[(size_t)j * INW]); o1 = fmaf(s1[j], v, o1); o2 = fmaf(s2[j], v, o2); }
    const float lam = lamp[layer];
    const float a = o1 / l1 - lam * (o2 / l2);
    float ss = a * a;
    for (int o = 1; o < 64; o <<= 1) ss += __shfl_xor(ss, o);
    __syncthreads();
    if ((tid & 63) == 0) red[tid >> 6] = ss;
    __syncthreads();
    ss = red[0] + red[1];
    const float y = a * (1.0f / sqrtf(ss * (1.0f / DV) + EPS)) * subln_g[tid] * one_minus_lam0;
    MIX[row * DM + h * 128 + tid] = (bf16)f2bf(y);
}
__global__ void __launch_bounds__(256) k_pool_naive(const bf16* __restrict__ PROJ, bf16* __restrict__ MIX) {
    const int idx = blockIdx.x * 256 + threadIdx.x, c = idx & 511, row = idx >> 9, t = row & (SEQ - 1), g = c >> 7, w = 2 << g;
    const int n = (t + 1 < w) ? (t + 1) : w;
    const bf16* up = PROJ + (size_t)row * INW + 3 * ATTW + c; float s = 0.f;
    for (int i = 0; i < n; ++i) s += bf2f(*(up - (size_t)i * INW));
    MIX[(size_t)row * DM + ATTW + c] = (bf16)f2bf(s / (float)n - bf2f(*up));
}
__global__ void __launch_bounds__(256) k_final(float* __restrict__ x, const float* __restrict__ g) {
    const int row = blockIdx.x * 4 + (threadIdx.x >> 6), lane = threadIdx.x & 63;
    f32x4* xr = (f32x4*)(x + (size_t)row * DM) + lane; const f32x4* gr = (const f32x4*)g + lane;
    f32x4 v[4]; float s = 0.f;
    for (int j = 0; j < 4; ++j) { v[j] = xr[64 * j]; s += (v[j].x * v[j].x + v[j].y * v[j].y) + (v[j].z * v[j].z + v[j].w * v[j].w); }
    for (int o = 1; o < 64; o <<= 1) s += __shfl_xor(s, o);
    const float r = 1.0f / sqrtf(s * (1.0f / DM) + EPS);
    for (int j = 0; j < 4; ++j) xr[64 * j] = v[j] * r * gr[64 * j];
}

extern "C" void kernel_launch(void* const* d_in, const int* in_sizes, int n_in, void* d_out, int out_size, void* d_ws, size_t ws_size, hipStream_t stream) {
    if (n_in != 13 || in_sizes[0] != M * DM || out_size != M * DM || ws_size < WS_END) { fprintf(stderr, "kernel_launch: unexpected shapes (n_in %d, ws %zu)\n", n_in, ws_size); return; }
    const float* x = (const float*)d_in[0]; const float* norm1_g = (const float*)d_in[1]; const float* w_in = (const float*)d_in[2]; const float* lam_qk = (const float*)d_in[3];
    const float* subln_g = (const float*)d_in[4]; const float* pool_w = (const float*)d_in[5]; const float* pool_scale = (const float*)d_in[6]; const float* w_out = (const float*)d_in[7];
    const float* norm2_g = (const float*)d_in[8]; const float* w_gate = (const float*)d_in[9]; const float* w_up = (const float*)d_in[10]; const float* w_down = (const float*)d_in[11];
    const float* final_g = (const float*)d_in[12];
    unsigned char* ws = (unsigned char*)d_ws; float* out = (float*)d_out;
    bf16* W1 = (bf16*)(ws + WS_W1); bf16* WO = (bf16*)(ws + WS_WO); bf16* WGU = (bf16*)(ws + WS_WGU); bf16* WD = (bf16*)(ws + WS_WD);
    float* SSQ = (float*)(ws + WS_SSQ); float* LAM = (float*)(ws + WS_LAM);
    bf16* XB = (bf16*)(ws + WS_XB); bf16* PROJ = (bf16*)(ws + WS_PROJ); bf16* MIX = (bf16*)(ws + WS_MIX); bf16* H = (bf16*)(ws + WS_H);
    const float lam0[2] = {0.8f - 0.6f * expf(-0.3f * 0.f), 0.8f - 0.6f * expf(-0.3f * 1.f)};
    for (int l = 0; l < DEPTH; ++l) {
        k_transpose<<<512, 256, 0, stream>>>(w_in + (size_t)l * DM * INW, DM, INW, W1 + (size_t)l * INW * DM, DM, 0, 0);
        k_transpose<<<512, 256, 0, stream>>>(w_out + (size_t)l * DM * DM, ATTW, DM, WO + (size_t)l * DM * DM, DM, 0, 0);
        k_transpose<<<512, 256, 0, stream>>>(w_gate + (size_t)l * DM * DFF, DM, DFF, WGU + (size_t)l * NGU * DM, DM, 0, 1);
        k_transpose<<<512, 256, 0, stream>>>(w_up + (size_t)l * DM * DFF, DM, DFF, WGU + (size_t)l * NGU * DM, DM, 128, 1);
        k_transpose<<<512, 256, 0, stream>>>(w_down + (size_t)l * DFF * DM, DFF, DM, WD + (size_t)l * DM * DFF, DFF, 0, 0);
        k_fold_pool<<<512 * 1024 / 256, 256, 0, stream>>>(pool_w + (size_t)l * 4 * 128 * 128, pool_scale + l * 512, w_out + (size_t)l * DM * DM, WO + (size_t)l * DM * DM);
    }
    k_lambda<<<1, 64, 0, stream>>>(lam_qk, LAM, lam0[0], lam0[1]);
    k_prep_x<<<M / 4, 256, 0, stream>>>(x, norm1_g, XB, SSQ);
    for (int l = 0; l < DEPTH; ++l) {
        { EpiArgs e{PROJ, nullptr, nullptr, SSQ, INW, 0}; k_gemm<EPI_PROJ, 1><<<dim3(INW / 128, M / 128), 256, 0, stream>>>(XB, W1 + (size_t)l * INW * DM, DM, e); }
        k_attn_naive<<<dim3(SEQ, NH, BATCH), 128, 0, stream>>>(PROJ, MIX, LAM, l, subln_g + l * DV, 1.0f - lam0[l]);
        k_pool_naive<<<M * 512 / 256, 256, 0, stream>>>(PROJ, MIX);
        { EpiArgs e{nullptr, out, l == 0 ? x : out, nullptr, DM, 0}; k_gemm<EPI_RES, 1><<<dim3(DM / 128, M / 128), 256, 0, stream>>>(MIX, WO + (size_t)l * DM * DM, DM, e); }
        k_prep_x<<<M / 4, 256, 0, stream>>>(out, norm2_g + l * DM, XB, SSQ);
        { EpiArgs e{H, nullptr, nullptr, SSQ, DFF, 0}; k_gemm<EPI_SWIGLU, 2><<<dim3(DFF / 128, M / 128), 256, 0, stream>>>(XB, WGU + (size_t)l * NGU * DM, DM, e); }
        { EpiArgs e{nullptr, out, out, nullptr, DM, 0}; k_gemm<EPI_RES, 1><<<dim3(DM / 128, M / 128), 256, 0, stream>>>(H, WD + (size_t)l * DM * DFF, DFF, e); }
        if (l + 1 < DEPTH) k_prep_x<<<M / 4, 256, 0, stream>>>(out, norm1_g + (l + 1) * DM, XB, SSQ);
    }
    k_final<<<M / 4, 256, 0, stream>>>(out, final_g);
}
```

```cpp
#include <hip/hip_runtime.h>
#include <cstdio>
#include <cstdint>
#include <cmath>

constexpr int BATCH = 8, SEQ = 2048, DM = 1024, DEPTH = 2, M = BATCH * SEQ;
constexpr int NH = 4, DV = 128, ATTW = 512, INW = 2048, DFF = 2816, NGU = 2 * DFF;
constexpr float EPS = 1e-5f;
constexpr float C2 = 0.125f * 1.4426950408889634f;
constexpr float LAM0_0 = 0.2f, LAM0_1 = 0.35550906759096926f;
constexpr int NSSQ = 16;

#define MK_ONE_LAUNCH 1
#define MK_NAIVE_MASK 0u
namespace pg8 {
#define PG8_LAS __attribute__((address_space(3)))
typedef unsigned short bf16_t;
typedef short bf16x8 __attribute__((ext_vector_type(8)));
typedef float f32x4 __attribute__((ext_vector_type(4)));
typedef unsigned u32x4 __attribute__((ext_vector_type(4)));
constexpr int BM = 256, BK = 64, HALF = 128, HTB = HALF * BK * 2  , STAGE_BYTES = 8 * HTB, NXCD = 8, WGM = 8;

__host__ __device__ __forceinline__ int lds_byte(int r, int c) { const int st = (r >> 4) * 2 + (c >> 5), rr = r & 15, cc = c & 31, ob = rr * 64 + cc * 2; return st * 1024 + (ob ^ (((ob >> 9) & 1) << 5)); }
__host__ __device__ __forceinline__ void stage_rc(int b, int& R, int& C) { const int st = b / 1024, sb = b % 1024, swz = sb ^ (((sb >> 9) & 1) << 5); R = (st >> 1) * 16 + swz / 64; C = (st & 1) * 32 + (swz % 64) / 2; }
__host__ __device__ __forceinline__ int perm32(int rho) { const int n = rho >> 4, i = rho & 15; return 8 * (i >> 2) + 4 * n + (i & 3); }

struct Unit { int pm, pn; };
struct Gemm { const bf16_t* A; const bf16_t* Bt; int M, N, K; };

struct StaticOrder {
    int nM, nN, nwg, G, c;
    __host__ __device__ void init(int M, int N, int G_, int c_) { nM = M / BM; nN = N / BM; nwg = nM * nN; G = G_; c = c_; }
    __host__ __device__ bool next(int i, Unit& u) const {
        const long L = (long)i * G + c; if (L >= nwg) return false;
        int wgid = (int)L; { const int q = nwg / NXCD, r = nwg % NXCD, xcd = wgid % NXCD, off = wgid / NXCD; wgid = (xcd < r ? xcd * (q + 1) : r * (q + 1) + (xcd - r) * q) + off; }
        const int nig = WGM * nN, gid = wgid / nig, fm = gid * WGM, gsz = (nM - fm) < WGM ? (nM - fm) : WGM;
        u.pm = fm + ((wgid % nig) % gsz); u.pn = (wgid % nig) / gsz; return true;
    }
    __device__ __forceinline__ void a_ready(const Unit&) const {}
    __device__ __forceinline__ void done(const Unit&) const {}
};

__device__ __forceinline__ unsigned cvt_pk_bf16(float lo, float hi) { unsigned r; asm volatile("v_cvt_pk_bf16_f32 %0, %1, %2" : "=v"(r) : "v"(lo), "v"(hi)); return r; }
__device__ __forceinline__ float rstd16(const float* SSQ, int row) {
    const f32x4* p = (const f32x4*)(SSQ + (size_t)row * NSSQ); const f32x4 a = p[0], b = p[1], c = p[2], d = p[3];
    const float s = ((a[0] + a[1]) + (a[2] + a[3])) + ((b[0] + b[1]) + (b[2] + b[3])) + ((c[0] + c[1]) + (c[2] + c[3])) + ((d[0] + d[1]) + (d[2] + d[3]));
    return 1.0f / sqrtf(s * (1.0f / DM) + EPS);
}
struct EpiProj {
    static constexpr bool PERM = true, AFTER_DRAIN = false;
    bf16_t* O; const float* SSQ;
    __device__ __forceinline__ void operator()(const f32x4 (&acc)[2][2][4][2], const Unit& u, int wr, int wc, int fr, int fq) const {
        const int row0 = u.pm * BM + wr * 64 + fr, col0 = u.pn * BM + wc * 32 + 8 * fq;
        const float qs = (u.pn < 2) ? C2 : 1.0f;
#pragma unroll
        for (int ai = 0; ai < 2; ++ai)
#pragma unroll
            for (int m = 0; m < 4; ++m) { const int row = row0 + ai * HALF + m * 16; const float r = rstd16(SSQ, row) * qs; bf16_t* rowp = O + (size_t)row * INW + col0;
#pragma unroll
                for (int bj = 0; bj < 2; ++bj) { const f32x4 v0 = acc[ai][bj][m][0] * r, v1 = acc[ai][bj][m][1] * r;
                    u32x4 w; w.x = cvt_pk_bf16(v0[0], v0[1]); w.y = cvt_pk_bf16(v0[2], v0[3]); w.z = cvt_pk_bf16(v1[0], v1[1]); w.w = cvt_pk_bf16(v1[2], v1[3]);
                    *(u32x4*)(rowp + bj * HALF) = w; } }
    }
};
struct EpiSwiglu {
    static constexpr bool PERM = true, AFTER_DRAIN = false;
    bf16_t* O; const float* SSQ;
    __device__ __forceinline__ void operator()(const f32x4 (&acc)[2][2][4][2], const Unit& u, int wr, int wc, int fr, int fq) const {
        const int row0 = u.pm * BM + wr * 64 + fr, col0 = u.pn * HALF + wc * 32 + 8 * fq;
#pragma unroll
        for (int ai = 0; ai < 2; ++ai)
#pragma unroll
            for (int m = 0; m < 4; ++m) { const int row = row0 + ai * HALF + m * 16; const float r = rstd16(SSQ, row); float hv[8];
#pragma unroll
                for (int n = 0; n < 2; ++n)
#pragma unroll
                    for (int q = 0; q < 4; ++q) { const float g = acc[ai][0][m][n][q] * r, up = acc[ai][1][m][n][q] * r;
                        hv[4 * n + q] = g * __builtin_amdgcn_rcpf(1.0f + __builtin_amdgcn_exp2f(-1.4426950408889634f * g)) * up; }
                u32x4 w; w.x = cvt_pk_bf16(hv[0], hv[1]); w.y = cvt_pk_bf16(hv[2], hv[3]); w.z = cvt_pk_bf16(hv[4], hv[5]); w.w = cvt_pk_bf16(hv[6], hv[7]);
                *(u32x4*)(O + (size_t)row * DFF + col0) = w; }
    }
};
struct EpiRes {
    static constexpr bool PERM = true, AFTER_DRAIN = false;
    const float* base; float* out; bf16_t* XB; const float* gain; float* SSQ;
    __device__ __forceinline__ void operator()(const f32x4 (&acc)[2][2][4][2], const Unit& u, int wr, int wc, int fr, int fq) const {
        const int row0 = u.pm * BM + wr * 64 + fr, col0 = u.pn * BM + wc * 32 + 8 * fq;
        f32x4 gv[2][2];
#pragma unroll
        for (int bj = 0; bj < 2; ++bj)
#pragma unroll
            for (int n = 0; n < 2; ++n) gv[bj][n] = XB ? *(const f32x4*)(gain + col0 + bj * HALF + 4 * n) : (f32x4){0.f, 0.f, 0.f, 0.f};
#pragma unroll
        for (int ai = 0; ai < 2; ++ai)
#pragma unroll
            for (int m = 0; m < 4; ++m) { const int row = row0 + ai * HALF + m * 16; const size_t off = (size_t)row * DM + col0; float ss = 0.f;
#pragma unroll
                for (int bj = 0; bj < 2; ++bj) { f32x4 x0 = *(const f32x4*)(base + off + bj * HALF), x1 = *(const f32x4*)(base + off + bj * HALF + 4);
                    x0 += acc[ai][bj][m][0]; x1 += acc[ai][bj][m][1];
                    *(f32x4*)(out + off + bj * HALF) = x0; *(f32x4*)(out + off + bj * HALF + 4) = x1;
                    ss += ((x0[0] * x0[0] + x0[1] * x0[1]) + (x0[2] * x0[2] + x0[3] * x0[3])) + ((x1[0] * x1[0] + x1[1] * x1[1]) + (x1[2] * x1[2] + x1[3] * x1[3]));
                    if (XB) { const f32x4 y0 = x0 * gv[bj][0], y1 = x1 * gv[bj][1];
                        u32x4 w; w.x = cvt_pk_bf16(y0[0], y0[1]); w.y = cvt_pk_bf16(y0[2], y0[3]); w.z = cvt_pk_bf16(y1[0], y1[1]); w.w = cvt_pk_bf16(y1[2], y1[3]);
                        *(u32x4*)(XB + off + bj * HALF) = w; } }
                ss += __shfl_xor(ss, 16); ss += __shfl_xor(ss, 32);
                if (fq == 0) SSQ[(size_t)row * NSSQ + 4 * u.pn + wc] = ss;
                asm volatile("" ::: "memory"); }
    }
};

template <class Epi, class Sched, bool ALIGN_EPI = false, bool SP2 = false>
__device__ __forceinline__ void gemm_phase(PG8_LAS unsigned char* lds, const Gemm g, const Sched& S, const Epi& E) {
    int tid_o = threadIdx.x; asm volatile("" : "+v"(tid_o));
    const int tid = tid_o, wid = __builtin_amdgcn_readfirstlane(tid >> 6), lane = tid & 63, wr = wid >> 2, wc = wid & 3, fr = lane & 15, fq = lane >> 4;
    const int K = g.K, nt = K / BK;
    unsigned voffA[2], voffB[2];
#pragma unroll
    for (int i = 0; i < 2; ++i) { int R, C; stage_rc(tid * 16 + i * 8192, R, C); const int Rb = Epi::PERM ? ((R & ~31) + perm32(R & 31)) : R;
        voffA[i] = (unsigned)(R * K + C) * 2u; voffB[i] = (unsigned)(Rb * K + C) * 2u; }
    const size_t kstep = (size_t)(BK * 2);
    const size_t hstep = (size_t)HALF * K * 2;
    const size_t tstep = 2 * hstep;
    const unsigned ldsw = (unsigned)wid * 1024u;
    const int aoff = lds_byte(wr * 64 + fr, fq * 8), boff = lds_byte(wc * 32 + fr, fq * 8);
#define PG8_SA(b, h) (((b) * 2 + (h)) * HTB)
#define PG8_SB(b, h) ((4 + (b) * 2 + (h)) * HTB)
#define PG8_STAGE(bufoff, gbase, voff) do { _Pragma("unroll") for (int _i = 0; _i < 2; ++_i) \
        __builtin_amdgcn_global_load_lds((const unsigned*)((const char*)(gbase) + (voff)[_i]), (PG8_LAS unsigned*)(lds + (bufoff) + ldsw + _i * 8192), 16, 0, 0); } while (0)
#define PG8_LDA(dst, b, h) do { _Pragma("unroll") for (int m = 0; m < 4; ++m) _Pragma("unroll") for (int k = 0; k < 2; ++k) dst[m][k] = *(const PG8_LAS bf16x8*)(lds + PG8_SA(b, h) + aoff + m * 2048 + k * 1024); } while (0)
#define PG8_LDB(dst, b, h) do { _Pragma("unroll") for (int n = 0; n < 2; ++n) _Pragma("unroll") for (int k = 0; k < 2; ++k) dst[n][k] = *(const PG8_LAS bf16x8*)(lds + PG8_SB(b, h) + boff + n * 2048 + k * 1024); } while (0)
#define PG8_MMA(ai, bj, At, Bt) do { __builtin_amdgcn_s_setprio(1); _Pragma("unroll") for (int m = 0; m < 4; ++m) _Pragma("unroll") for (int n = 0; n < 2; ++n) _Pragma("unroll") for (int k = 0; k < 2; ++k) \
        acc[ai][bj][m][n] = __builtin_amdgcn_mfma_f32_16x16x32_bf16(Bt[n][k], At[m][k], acc[ai][bj][m][n], 0, 0, 0); __builtin_amdgcn_s_setprio(0); } while (0)
#define PG8_WAIT_V(n) asm volatile("s_waitcnt vmcnt(" #n ")" ::: "memory")
#define PG8_WAIT_L(n) asm volatile("s_waitcnt lgkmcnt(" #n ")" ::: "memory")
#define PG8_BAR __builtin_amdgcn_s_barrier()
#define PG8_SCHED __builtin_amdgcn_sched_barrier(0)
    Unit cur, nxt; int ui = 0;
    if (!S.next(0, cur)) return;
    f32x4 acc[2][2][4][2];
#pragma unroll
    for (int a = 0; a < 2; ++a)
#pragma unroll
        for (int b = 0; b < 2; ++b)
#pragma unroll
            for (int m = 0; m < 4; ++m)
#pragma unroll
                for (int n = 0; n < 2; ++n) acc[a][b][m][n] = (f32x4){0.f, 0.f, 0.f, 0.f};
    bf16x8 At[4][2], B0[2][2], B1[2][2];
    const char* cA = (const char*)g.A + (size_t)cur.pm * tstep; const char* cB = (const char*)g.Bt + (size_t)cur.pn * tstep;
    S.a_ready(cur);
    if constexpr (SP2) {
        PG8_STAGE(PG8_SB(0, 0), cB, voffB); PG8_STAGE(PG8_SB(0, 1), cB + hstep, voffB); PG8_STAGE(PG8_SA(0, 0), cA, voffA); PG8_STAGE(PG8_SA(0, 1), cA + hstep, voffA);
        if (wr == 1) PG8_BAR;
        PG8_WAIT_V(2); PG8_BAR;
        PG8_STAGE(PG8_SB(1, 0), cB + kstep, voffB); PG8_STAGE(PG8_SA(1, 0), cA + kstep, voffA); PG8_STAGE(PG8_SB(1, 1), cB + hstep + kstep, voffB);
        PG8_WAIT_V(6); PG8_BAR;
    } else {
        PG8_STAGE(PG8_SB(0, 0), cB, voffB); PG8_STAGE(PG8_SA(0, 0), cA, voffA); PG8_STAGE(PG8_SB(0, 1), cB + hstep, voffB); PG8_STAGE(PG8_SA(0, 1), cA + hstep, voffA);
        if (wr == 1) PG8_BAR;
        PG8_WAIT_V(4); PG8_BAR;
        PG8_STAGE(PG8_SB(1, 0), cB + kstep, voffB); PG8_STAGE(PG8_SA(1, 0), cA + kstep, voffA); PG8_STAGE(PG8_SB(1, 1), cB + hstep + kstep, voffB);
        PG8_WAIT_V(6); PG8_BAR;
    }
    for (;;) {
        const bool has_next = S.next(ui + 1, nxt);
        const char* nA = has_next ? (const char*)g.A + (size_t)nxt.pm * tstep : cA; const char* nB = has_next ? (const char*)g.Bt + (size_t)nxt.pn * tstep : cB;
        for (int t = 0; t < nt; t += 2) {
            const bool last = (t == nt - 2);
            const char* a1 = cA + (size_t)(t + 1) * kstep;
            const char* a2 = last ? nA : cA + (size_t)(t + 2) * kstep; const char* b2 = last ? nB : cB + (size_t)(t + 2) * kstep;
            const char* a3 = a2 + kstep; const char* b3 = b2 + kstep;
            if (last && has_next) S.a_ready(nxt);
            if constexpr (SP2) {
            PG8_LDB(B0, 0, 0); PG8_LDB(B1, 0, 1); PG8_SCHED; PG8_LDA(At, 0, 0); PG8_STAGE(PG8_SA(1, 1), a1 + hstep, voffA);
            PG8_WAIT_V(8); PG8_WAIT_L(0); PG8_BAR; PG8_MMA(0, 0, At, B0); PG8_MMA(0, 1, At, B1); PG8_BAR; PG8_SCHED;
            PG8_LDA(At, 0, 1); PG8_STAGE(PG8_SB(0, 0), b2, voffB); PG8_STAGE(PG8_SB(0, 1), b2 + hstep, voffB); PG8_STAGE(PG8_SA(0, 0), a2, voffA);
            PG8_WAIT_V(8); PG8_WAIT_L(0); PG8_BAR; PG8_MMA(1, 0, At, B0); PG8_MMA(1, 1, At, B1); PG8_BAR; PG8_SCHED;
            PG8_LDB(B0, 1, 0); PG8_LDB(B1, 1, 1); PG8_SCHED; PG8_LDA(At, 1, 0); PG8_STAGE(PG8_SA(0, 1), a2 + hstep, voffA);
            PG8_WAIT_V(8); PG8_WAIT_L(0); PG8_BAR; PG8_MMA(0, 0, At, B0); PG8_MMA(0, 1, At, B1); PG8_BAR; PG8_SCHED;
            PG8_LDA(At, 1, 1); PG8_STAGE(PG8_SB(1, 0), b3, voffB); PG8_STAGE(PG8_SB(1, 1), b3 + hstep, voffB); PG8_STAGE(PG8_SA(1, 0), a3, voffA);
            PG8_WAIT_V(8); PG8_WAIT_L(0); PG8_BAR; PG8_MMA(1, 0, At, B0); PG8_MMA(1, 1, At, B1); PG8_BAR; PG8_SCHED;
            } else {
            PG8_LDB(B0, 0, 0); PG8_SCHED; PG8_LDA(At, 0, 0); PG8_STAGE(PG8_SA(1, 1), a1 + hstep, voffA);
            PG8_WAIT_L(8); PG8_BAR; PG8_WAIT_L(0); PG8_MMA(0, 0, At, B0); PG8_BAR; PG8_SCHED;
            PG8_LDB(B1, 0, 1); PG8_STAGE(PG8_SB(0, 0), b2, voffB);
            PG8_BAR; PG8_WAIT_L(0); PG8_MMA(0, 1, At, B1); PG8_BAR;
            PG8_LDA(At, 0, 1); PG8_STAGE(PG8_SA(0, 0), a2, voffA);
            PG8_BAR; PG8_WAIT_L(0); PG8_MMA(1, 0, At, B0); PG8_BAR; PG8_SCHED;
            PG8_STAGE(PG8_SB(0, 1), b2 + hstep, voffB);
            PG8_WAIT_V(6); PG8_BAR; PG8_MMA(1, 1, At, B1); PG8_BAR;
            PG8_LDB(B0, 1, 0); PG8_SCHED; PG8_LDA(At, 1, 0); PG8_STAGE(PG8_SA(0, 1), a2 + hstep, voffA);
            PG8_WAIT_L(8); PG8_BAR; PG8_WAIT_L(0); PG8_MMA(0, 0, At, B0); PG8_BAR; PG8_SCHED;
            PG8_LDB(B1, 1, 1); PG8_STAGE(PG8_SB(1, 0), b3, voffB);
            PG8_BAR; PG8_WAIT_L(0); PG8_MMA(0, 1, At, B1); PG8_BAR;
            PG8_LDA(At, 1, 1); PG8_STAGE(PG8_SA(1, 0), a3, voffA);
            PG8_BAR; PG8_WAIT_L(0); PG8_MMA(1, 0, At, B0); PG8_BAR; PG8_SCHED;
            PG8_STAGE(PG8_SB(1, 1), b3 + hstep, voffB);
            PG8_WAIT_V(6); PG8_BAR; PG8_MMA(1, 1, At, B1); PG8_BAR;
            }
        }
        if constexpr (ALIGN_EPI) { if (wr == 0) PG8_BAR; }
        if constexpr (!Epi::AFTER_DRAIN) { E(acc, cur, wr, wc, fr, fq); S.done(cur); }
        if (!has_next) break;
#pragma unroll
        for (int a = 0; a < 2; ++a)
#pragma unroll
            for (int b = 0; b < 2; ++b)
#pragma unroll
                for (int m = 0; m < 4; ++m)
#pragma unroll
                    for (int n = 0; n < 2; ++n) acc[a][b][m][n] = (f32x4){0.f, 0.f, 0.f, 0.f};
        cur = nxt; cA = nA; cB = nB; ++ui;
        if constexpr (ALIGN_EPI) { if (wr == 1) PG8_BAR; }
    }
    PG8_WAIT_V(0);
    if constexpr (!ALIGN_EPI) { if (wr == 0) PG8_BAR; }
    PG8_BAR;
    if constexpr (Epi::AFTER_DRAIN) { E.fused(acc, cur, wr, wc, fr, fq, lds, wid, lane); S.done(cur); }
#undef PG8_SA
#undef PG8_SB
#undef PG8_STAGE
#undef PG8_LDA
#undef PG8_LDB
#undef PG8_MMA
#undef PG8_WAIT_V
#undef PG8_WAIT_L
#undef PG8_BAR
#undef PG8_SCHED
}
}
namespace dattn {
typedef unsigned short bf16_t;
typedef short bf16x8 __attribute__((ext_vector_type(8)));
typedef short s16x4 __attribute__((ext_vector_type(4)));
typedef float f32x16 __attribute__((ext_vector_type(16)));
typedef float f32x4 __attribute__((ext_vector_type(4)));
typedef unsigned u32x4 __attribute__((ext_vector_type(4)));
typedef short v4i16_t __attribute__((ext_vector_type(4)));
#define DA_LAS __attribute__((address_space(3)))
typedef DA_LAS const char* lds_cptr;
constexpr int QB = 128, KVBLK = 64, PITCH = INW, NSLOT = 3, SLOTB = 16384;
constexpr int LDS_K = 0, LDS_V = NSLOT * SLOTB, LDS_WS = 2 * NSLOT * SLOTB, LDS_BYTES = LDS_WS + 8 * 256;
constexpr int LDS_XCH = 0;
constexpr float THR = 6.0f;
__device__ __forceinline__ int crow(int r, int hi) { return (r & 3) + 8 * (r >> 2) + 4 * hi; }
__device__ __forceinline__ void glds16(const void* gsrc, unsigned lds_dst) { unsigned keep;
    asm volatile("s_mov_b32 %0, m0\n\ts_mov_b32 m0, %2\n\ts_nop 0\n\tglobal_load_lds_dwordx4 %1, off\n\ts_mov_b32 m0, %0" : "=&s"(keep) : "v"(gsrc), "s"(lds_dst) : "memory"); }
typedef float f32x2_t __attribute__((ext_vector_type(2))); typedef __bf16 bf16x2_t __attribute__((ext_vector_type(2)));
__device__ __forceinline__ unsigned cvtpk_s(float lo, float hi) { f32x2_t v = {lo, hi}; bf16x2_t b = __builtin_convertvector(v, bf16x2_t); return __builtin_bit_cast(unsigned, b); }
__device__ __forceinline__ s16x4 vtr(lds_cptr p) { return __builtin_bit_cast(s16x4, __builtin_amdgcn_ds_read_tr16_b64_v4i16((DA_LAS v4i16_t*)p)); }
#define DA_WAIT_BAR(N) asm volatile("s_waitcnt vmcnt(" #N ") lgkmcnt(0)\n\ts_barrier" ::: "memory")
#define DA_MFMA(a, b, c) __builtin_amdgcn_mfma_f32_32x32x16_bf16(a, b, c, 0, 0, 0)

__device__ __forceinline__ void attn_unit(int b, int h, int qb, const bf16_t* PROJ, bf16_t* MIX, float lam, const float* sg, float oml0, char* shm) {
    int tid_o = threadIdx.x; asm volatile("" : "+v"(tid_o));
    const int tid = tid_o, lane = tid & 63, r32 = lane & 31, hi = lane >> 5;
    const int wid = __builtin_amdgcn_readfirstlane(tid >> 6), c = wid >> 2, wq = wid & 3;
    const long rowbase = (long)b * SEQ; const int q0 = qb * QB;
    const bf16_t* Qw = PROJ + (rowbase + q0 + wq * 32) * PITCH + h * 128 + c * 64;
    const bf16_t* Kh = PROJ + rowbase * PITCH + ATTW + h * 128;
    const bf16_t* Vh = PROJ + rowbase * PITCH + 2 * ATTW + h * 128;
    const unsigned lds0 = (unsigned)(uintptr_t)shm;
    const lds_cptr shm3 = (lds_cptr)shm;
    DA_LAS float* wsf = (DA_LAS float*)(shm3 + LDS_WS) + wid * 64;
    const bf16_t* ksrc = Kh + (long)lane * PITCH + wid * 8;
    const bf16_t* vsrc = Vh + (long)(16 * (wid & 3) + (lane >> 2)) * PITCH + (wid >> 2) * 32 + (lane & 3) * 8;
    const unsigned kdst = lds0 + LDS_K + wid * 1024, vdst = lds0 + LDS_V + wid * 1024;
#define DA_RFL(x) ((unsigned)__builtin_amdgcn_readfirstlane((int)(x)))
#define DA_DMA_TILE(t, slot) do { const long go_ = (long)(t) * KVBLK * PITCH; const unsigned so_ = (unsigned)(slot); \
        glds16(ksrc + go_, DA_RFL(kdst + so_)); glds16(ksrc + go_ + 64, DA_RFL(kdst + so_ + 8192)); \
        glds16(vsrc + go_, DA_RFL(vdst + so_)); glds16(vsrc + go_ + 64, DA_RFL(vdst + so_ + 8192)); } while (0)
    const int NT = 2 * (qb + 1);
    DA_DMA_TILE(0, 0); DA_DMA_TILE(1, SLOTB);
    bf16x8 qr[4];
#pragma unroll
    for (int d0 = 0; d0 < 4; ++d0) qr[d0] = *(const bf16x8*)(Qw + (long)r32 * PITCH + d0 * 16 + hi * 8);
    float m = -1e30f, l = 0.f;
    f32x16 o[4];
#pragma unroll
    for (int i = 0; i < 4; ++i) o[i] = f32x16{};
    int s_cur = 0, s_nxt = SLOTB, s_free = 2 * SLOTB;
    const lds_cptr kp0 = shm3 + LDS_K + c * 8192 + hi * 1024 + r32 * 16;
    const lds_cptr vp0 = shm3 + LDS_V + ((lane >> 4) & 1) * 32 + (lane & 3) * 8 + (4 * hi + ((lane & 15) >> 2)) * 64;
    const int qrel = wq * 32 + r32;
    for (int t = 0; t < NT; ++t) {
        if (t + 1 < NT) { DA_WAIT_BAR(4); } else { DA_WAIT_BAR(0); }
        if (t + 2 < NT) DA_DMA_TILE(t + 2, s_free);
        f32x16 p0 = f32x16{}, p1 = f32x16{};
        { const lds_cptr kp = kp0 + s_cur;
#pragma unroll
          for (int d0 = 0; d0 < 4; ++d0) { const bf16x8 b0 = *(const DA_LAS bf16x8*)(kp + d0 * 2048), b1 = *(const DA_LAS bf16x8*)(kp + d0 * 2048 + 512);
              p0 = DA_MFMA(b0, qr[d0], p0); p1 = DA_MFMA(b1, qr[d0], p1); } }
        if (t >= NT - 2) { const int kb = 64 * (t - (NT - 2)) + 4 * hi;
#pragma unroll
            for (int r = 0; r < 16; ++r) { const int kv = kb + (r & 3) + 8 * (r >> 2); if (kv > qrel) p0[r] = -INFINITY; if (kv + 32 > qrel) p1[r] = -INFINITY; } }
        float rm = fmaxf(p0[0], p1[0]);
#pragma unroll
        for (int r = 1; r < 16; ++r) rm = fmaxf(rm, fmaxf(p0[r], p1[r]));
        { auto rr = __builtin_amdgcn_permlane32_swap(__float_as_uint(rm), __float_as_uint(rm), false, false); rm = fmaxf(__uint_as_float(rr[0]), __uint_as_float(rr[1])); }
        if (__any(rm > m + THR)) {
            const float mn = fmaxf(m, rm), f = __builtin_amdgcn_exp2f(m - mn); m = mn; l *= f;
            if (hi == 0) wsf[r32] = f;
#pragma unroll
            for (int r = 0; r < 16; ++r) { const float fr_ = wsf[crow(r, hi)];
#pragma unroll
                for (int db = 0; db < 4; ++db) o[db][r] *= fr_; }
        }
        float sacc = 0.f;
#pragma unroll
        for (int r = 0; r < 16; ++r) { p0[r] = __builtin_amdgcn_exp2f(p0[r] - m); p1[r] = __builtin_amdgcn_exp2f(p1[r] - m); sacc += p0[r] + p1[r]; }
        l += sacc;
        u32x4 pw[4];
#pragma unroll
        for (int i = 0; i < 4; ++i) { pw[0][i] = cvtpk_s(p0[2 * i], p0[2 * i + 1]); pw[1][i] = cvtpk_s(p0[8 + 2 * i], p0[9 + 2 * i]); pw[2][i] = cvtpk_s(p1[2 * i], p1[2 * i + 1]); pw[3][i] = cvtpk_s(p1[8 + 2 * i], p1[9 + 2 * i]); }
        { const lds_cptr vp = vp0 + s_cur;
#pragma unroll
          for (int db = 0; db < 4; ++db)
#pragma unroll
              for (int ks = 0; ks < 4; ++ks) { const s16x4 lo = vtr(vp + db * 4096 + ks * 1024), hv = vtr(vp + db * 4096 + ks * 1024 + 512);
                  const bf16x8 vf = (bf16x8){lo[0], lo[1], lo[2], lo[3], hv[0], hv[1], hv[2], hv[3]};
                  o[db] = DA_MFMA(__builtin_bit_cast(bf16x8, pw[ks]), vf, o[db]); } }
        { const int tmp = s_cur; s_cur = s_nxt; s_nxt = s_free; s_free = tmp; }
    }
    { auto rr = __builtin_amdgcn_permlane32_swap(__float_as_uint(l), __float_as_uint(l), false, false); l = __uint_as_float(rr[0]) + __uint_as_float(rr[1]); }
    if (hi == 0) wsf[32 + r32] = (c == 1 ? lam : 1.0f) / l;
    asm volatile("s_waitcnt lgkmcnt(0)\n\ts_barrier" ::: "memory");
    DA_LAS float* xch = (DA_LAS float*)(shm3 + LDS_XCH) + wq * 4096;
    if (c == 1) {
#pragma unroll
        for (int r = 0; r < 16; ++r) { const float rl = wsf[32 + crow(r, hi)];
#pragma unroll
            for (int db = 0; db < 4; ++db) xch[(db * 16 + r) * 64 + lane] = o[db][r] * rl; }
    }
    asm volatile("s_waitcnt lgkmcnt(0)\n\ts_barrier" ::: "memory");
    if (c == 0) {
#pragma unroll
        for (int r = 0; r < 16; ++r) { const float rl = wsf[32 + crow(r, hi)];
#pragma unroll
            for (int db = 0; db < 4; ++db) o[db][r] = o[db][r] * rl - xch[(db * 16 + r) * 64 + lane]; }
        asm volatile("s_waitcnt lgkmcnt(0)" ::: "memory");
#pragma unroll
        for (int r = 0; r < 16; ++r)
#pragma unroll
            for (int db = 0; db < 4; ++db) xch[crow(r, hi) * 128 + db * 32 + r32] = o[db][r];
        asm volatile("s_waitcnt lgkmcnt(0)" ::: "memory");
        const int dcol = 8 * (lane & 15);
        const f32x4 g0 = *(const f32x4*)(sg + dcol), g1 = *(const f32x4*)(sg + dcol + 4);
        bf16_t* Ow = MIX + (rowbase + q0 + wq * 32) * DM + h * 128 + dcol;
#pragma unroll
        for (int i = 0; i < 8; ++i) { const int row = 4 * i + (lane >> 4);
            const f32x4 v0 = *(const DA_LAS f32x4*)(xch + row * 128 + dcol), v1 = *(const DA_LAS f32x4*)(xch + row * 128 + dcol + 4);
            float ss = ((v0[0] * v0[0] + v0[1] * v0[1]) + (v0[2] * v0[2] + v0[3] * v0[3])) + ((v1[0] * v1[0] + v1[1] * v1[1]) + (v1[2] * v1[2] + v1[3] * v1[3]));
            ss += __shfl_xor(ss, 1); ss += __shfl_xor(ss, 2); ss += __shfl_xor(ss, 4); ss += __shfl_xor(ss, 8);
            const float rs = oml0 / sqrtf(ss * (1.0f / DV) + EPS);
            const f32x4 y0 = v0 * g0 * rs, y1 = v1 * g1 * rs;
            u32x4 w; w.x = cvtpk_s(y0[0], y0[1]); w.y = cvtpk_s(y0[2], y0[3]); w.z = cvtpk_s(y1[0], y1[1]); w.w = cvtpk_s(y1[2], y1[3]);
            *(u32x4*)(Ow + (long)row * DM) = w; }
    }
    asm volatile("s_waitcnt lgkmcnt(0)\n\ts_barrier" ::: "memory");
#undef DA_DMA_TILE
#undef DA_RFL
}
__device__ __forceinline__ void pool_item(const bf16_t* PROJ, bf16_t* MIX, int row, int cg) {
    const int c8 = cg * 8, w = 2 << (cg >> 4), t = row & (SEQ - 1), n = (t + 1 < w) ? (t + 1) : w;
    const bf16_t* up = PROJ + (size_t)row * INW + 3 * ATTW + c8;
    float s[8];
#pragma unroll
    for (int j = 0; j < 8; ++j) s[j] = 0.f;
    u32x4 cur = *(const u32x4*)up;
    for (int i = 0; i < n; ++i) { const u32x4 v = *(const u32x4*)(up - (size_t)i * INW);
#pragma unroll
        for (int j = 0; j < 4; ++j) { s[2 * j] += __uint_as_float(v[j] << 16); s[2 * j + 1] += __uint_as_float(v[j] & 0xffff0000u); } }
    const float rn = 1.0f / (float)n; u32x4 o;
#pragma unroll
    for (int j = 0; j < 4; ++j) o[j] = cvtpk_s(s[2 * j] * rn - __uint_as_float(cur[j] << 16), s[2 * j + 1] * rn - __uint_as_float(cur[j] & 0xffff0000u));
    *(u32x4*)(MIX + (size_t)row * DM + ATTW + c8) = o;
}
__device__ __forceinline__ void attn_pool_phase(char* lds, const bf16_t* PROJ, bf16_t* MIX, const float* lam_qk, float lam0, const float* sg, int vcu, int G) {
    const int lane = threadIdx.x & 63;
    float s1 = lam_qk[lane] * lam_qk[64 + lane], s2 = lam_qk[128 + lane] * lam_qk[192 + lane];
#pragma unroll
    for (int o = 1; o < 64; o <<= 1) { s1 += __shfl_xor(s1, o); s2 += __shfl_xor(s2, o); }
    const float lam = expf(s1) - expf(s2) + lam0;
    for (int v = vcu; v < BATCH * NH * 8; v += G) { const int bh = v >> 3, s = v & 7;
        attn_unit(bh >> 2, bh & 3, s, PROJ, MIX, lam, sg, 1.0f - lam0, lds);
        attn_unit(bh >> 2, bh & 3, 15 - s, PROJ, MIX, lam, sg, 1.0f - lam0, lds); }
    for (int it = vcu * 512 + (int)threadIdx.x; it < M * 64; it += G * 512) pool_item(PROJ, MIX, it >> 6, it & 63);
}
#undef DA_WAIT_BAR
#undef DA_MFMA
}

constexpr int NWAVES = 8;
constexpr int NPHASE = 2 + 5 * DEPTH;
constexpr size_t MiB = 1u << 20;
constexpr size_t WS_CTL = 0, CTL_ZERO_BYTES = 65536;
constexpr size_t WS_W1 = 1 * MiB;
constexpr size_t WS_WO = 9 * MiB;
constexpr size_t WS_WGU = 13 * MiB;
constexpr size_t WS_WD = 35 * MiB;
constexpr size_t WS_SSQ = 46 * MiB;
constexpr size_t WS_XB = 48 * MiB;
constexpr size_t WS_PROJ = 80 * MiB;
constexpr size_t WS_MIX = 144 * MiB;
constexpr size_t WS_H = 80 * MiB;
constexpr size_t WS_END = 176 * MiB;
static_assert(WS_H + (size_t)M * DFF * 2 <= WS_END && WS_MIX + (size_t)M * DM * 2 <= WS_END && WS_SSQ + (size_t)M * NSSQ * 4 <= WS_XB, "ws map");
constexpr int CW_BAR = 1024;
constexpr int RING_OFF = 0, RING_BYTES = 131072;
constexpr int LDSCTL_OFF = RING_BYTES, MISC_OFF = LDSCTL_OFF + 320;
constexpr int LDS_BYTES = 147456;
static_assert(MISC_OFF + 128 <= LDS_BYTES && dattn::LDS_BYTES <= RING_BYTES && pg8::STAGE_BYTES <= RING_BYTES, "LDS map");

#define GAS __attribute__((address_space(1)))
#define LAS __attribute__((address_space(3)))
typedef unsigned short bf16;
typedef unsigned v4u __attribute__((ext_vector_type(4)));
typedef unsigned v2u __attribute__((ext_vector_type(2)));
typedef float f32x4 __attribute__((ext_vector_type(4)));
typedef short bf16x8 __attribute__((ext_vector_type(8)));
typedef GAS unsigned gu32;
#define RLX_AGENT __ATOMIC_RELAXED, __HIP_MEMORY_SCOPE_AGENT
#define LDS_WAIT() asm volatile("s_waitcnt lgkmcnt(0)" ::: "memory")
__device__ __forceinline__ unsigned f2bf(float f) { unsigned u = __builtin_bit_cast(unsigned, f); return (u + 0x7fffu + ((u >> 16) & 1u)) >> 16; }
__device__ __forceinline__ unsigned pk2(float lo, float hi) { return f2bf(lo) | (f2bf(hi) << 16); }
__device__ __forceinline__ float bf2f(bf16 b) { return __builtin_bit_cast(float, (unsigned)b << 16); }

#define XB_TMO      128
#define XB_XCNT(j)  (256  + 64 * (j))
#define XB_XSUB(j)  (1280 + 64 * (j))
#define XB_XGEN(j)  (2304 + 64 * (j))
#define XB_TOP      3328
#define XB_TOPGEN   3392
#define XCD_BAR_WORDS 3456
#define XB_SPIN_CAP (1u << 18)

__device__ __forceinline__ unsigned xb_ld(unsigned* p)              { return __hip_atomic_load(p, __ATOMIC_RELAXED, __HIP_MEMORY_SCOPE_AGENT); }
__device__ __forceinline__ unsigned xb_add(unsigned* p, unsigned v) { return __hip_atomic_fetch_add(p, v, __ATOMIC_RELAXED, __HIP_MEMORY_SCOPE_AGENT); }
__device__ __forceinline__ unsigned xb_xcc_id() { return (unsigned)__builtin_amdgcn_s_getreg((3 << 11) | 20) & 0xFu; }
#define XB_SPIN(cond, bar) do { unsigned _sp = 0; while (cond) { __builtin_amdgcn_s_sleep(1); \
    if ((++_sp & 255u) == 0u) { if (xb_ld(&(bar)[XB_TMO])) break; if (_sp > XB_SPIN_CAP) { atomicAdd(&(bar)[XB_TMO], 1u); break; } } } } while (0)

struct XcdBarrier {
    unsigned* bar; unsigned x;
    volatile LAS unsigned* st;
};

__device__ __forceinline__ XcdBarrier xcd_barrier_post(unsigned* bar, volatile LAS unsigned* st) {
    XcdBarrier b; b.bar = bar; b.x = xb_xcc_id(); b.st = st;
    if (threadIdx.x == 0) (void)xb_add(&bar[XB_XCNT(b.x)], 1u);
    return b;
}
__device__ __forceinline__ void xcd_barrier_complete(unsigned* bar, unsigned x, unsigned& nloc, unsigned& nx) {
    const unsigned G = gridDim.x * gridDim.y * gridDim.z;
    unsigned sum, cnt, mine, sp = 0u;
    for (;;) {
        sum = 0u; cnt = 0u; mine = 0u;
#pragma unroll
        for (unsigned j = 0; j < 16; ++j) { const unsigned c = xb_ld(&bar[XB_XCNT(j)]); sum += c; cnt += (c > 0u) ? 1u : 0u; mine = (j == x) ? c : mine; }
        if (sum == G) break;
        __builtin_amdgcn_s_sleep(1);
        if ((++sp & 255u) == 0u) { if (xb_ld(&bar[XB_TMO])) break; if (sp > XB_SPIN_CAP) { atomicAdd(&bar[XB_TMO], 1u); break; } }
    }
    nloc = mine > 0u ? mine : 1u; nx = cnt > 0u ? cnt : 1u;
}

__device__ __forceinline__ void xcd_barrier(const XcdBarrier& b) {
    asm volatile("s_waitcnt vmcnt(0)" ::: "memory");
    __syncthreads();
    if (threadIdx.x == 0) {
        unsigned* bar = b.bar;
        __builtin_amdgcn_s_waitcnt(0);
        unsigned nloc = b.st[0], nx = b.st[1];
        if (nloc == 0u) { xcd_barrier_complete(bar, b.x, nloc, nx); b.st[0] = nloc; b.st[1] = nx; }
        const unsigned old = xb_add(&bar[XB_XSUB(b.x)], 1u);
        const unsigned gen = old / nloc;
        if (old + 1u == (gen + 1u) * nloc) {
            __builtin_amdgcn_fence(__ATOMIC_RELEASE, "agent");
            asm volatile("s_waitcnt vmcnt(0)" ::: "memory");
            const unsigned og = xb_add(&bar[XB_TOP], 1u);
            const unsigned tg = og / nx;
            if (og + 1u == (tg + 1u) * nx) xb_add(&bar[XB_TOPGEN], 1u);
            else XB_SPIN(xb_ld(&bar[XB_TOPGEN]) == tg, bar);
            __builtin_amdgcn_fence(__ATOMIC_ACQUIRE, "agent");
            xb_add(&bar[XB_XGEN(b.x)], 1u);
            asm volatile("s_waitcnt vmcnt(0)" ::: "memory");
        } else {
            XB_SPIN(xb_ld(&bar[XB_XGEN(b.x)]) == gen, bar);
            __builtin_amdgcn_fence(__ATOMIC_ACQUIRE, "agent");
            asm volatile("s_waitcnt vmcnt(0)" ::: "memory");
        }
    }
    __syncthreads();
}

__device__ __forceinline__ float wave_sum(float v) {
#pragma unroll
    for (int o = 1; o < 64; o <<= 1) v += __shfl_xor(v, o);
    return v;
}
__device__ __forceinline__ void transpose_item(const float* W, int N, bf16* WT, int ldk, int k0, int n0, int rbase, LAS float* scr, int lane) {
#pragma unroll 8
    for (int i = 0; i < 32; ++i) { const int kk = 2 * i + (lane >> 5); scr[kk * 33 + (lane & 31)] = W[(size_t)(k0 + kk) * N + n0 + (lane & 31)]; }
    LDS_WAIT(); asm volatile("" ::: "memory");
    const int c = lane & 7;
#pragma unroll
    for (int j = 0; j < 4; ++j) { const int n = (lane >> 3) + 8 * j; const LAS float* s = scr + (8 * c) * 33 + n;
        v4u o; o.x = pk2(s[0 * 33], s[1 * 33]); o.y = pk2(s[2 * 33], s[3 * 33]); o.z = pk2(s[4 * 33], s[5 * 33]); o.w = pk2(s[6 * 33], s[7 * 33]);
        *(GAS v4u*)(WT + (size_t)(rbase + n) * ldk + k0 + 8 * c) = o; }
    LDS_WAIT(); asm volatile("" ::: "memory");
}
struct Ptrs {
    const float *x, *norm1_g, *w_in, *lam_qk, *subln_g, *pool_w, *pool_scale, *w_out, *norm2_g, *w_gate, *w_up, *w_down, *final_g;
    float* out; bf16 *W1, *WO, *WGU, *WD, *XB, *PROJ, *MIX, *H; float* SSQ;
};
__device__ __forceinline__ void p0_prologue(const Ptrs& P, LAS unsigned char* lds, int vcu, int G, int wave, int lane) {
    LAS float* scr = (LAS float*)(lds + RING_OFF + wave * 16384);
    const int gw = vcu * NWAVES + wave, NGW = G * NWAVES;
    constexpr int I_IN = (DM / 64) * (INW / 32), I_OUT = (ATTW / 64) * (DM / 32), I_G = (DM / 64) * (DFF / 32), I_D = (DFF / 64) * (DM / 32), I_LAYER = I_IN + I_OUT + 2 * I_G + I_D;
    for (int it = gw; it < DEPTH * I_LAYER; it += NGW) {
        const int l = it / I_LAYER; int r = it % I_LAYER;
        if (r < I_IN) { const int nb = INW / 32; transpose_item(P.w_in + (size_t)l * DM * INW, INW, P.W1 + (size_t)l * INW * DM, DM, 64 * (r / nb), 32 * (r % nb), 32 * (r % nb), scr, lane); continue; } r -= I_IN;
        if (r < I_OUT) { const int nb = DM / 32; transpose_item(P.w_out + (size_t)l * DM * DM, DM, P.WO + (size_t)l * DM * DM, DM, 64 * (r / nb), 32 * (r % nb), 32 * (r % nb), scr, lane); continue; } r -= I_OUT;
        if (r < 2 * I_G) { const int up = r >= I_G; if (up) r -= I_G; const int nb = DFF / 32, n0 = 32 * (r % nb);
            transpose_item((up ? P.w_up : P.w_gate) + (size_t)l * DM * DFF, DFF, P.WGU + (size_t)l * NGU * DM, DM, 64 * (r / nb), n0, 256 * (n0 / 128) + (n0 % 128) + 128 * up, scr, lane); continue; } r -= 2 * I_G;
        { const int nb = DM / 32; transpose_item(P.w_down + (size_t)l * DFF * DM, DM, P.WD + (size_t)l * DM * DFF, DFF, 64 * (r / nb), 32 * (r % nb), 32 * (r % nb), scr, lane); }
    }
    for (int idx = vcu * 512 + (int)threadIdx.x; idx < DEPTH * 512 * 1024; idx += G * 512) {
        const int l = idx >> 19, n = idx & 1023, gc = (idx >> 10) & 511, g = gc >> 7, c = gc & 127;
        const float* pw = P.pool_w + (size_t)l * 4 * 128 * 128 + ((size_t)g * 128 + c) * 128; const float* sc = P.pool_scale + l * 512 + 128 * g;
        const float* wo = P.w_out + (size_t)l * DM * DM + (size_t)(512 + 128 * g) * DM + n;
        float acc = 0.f;
#pragma unroll 8
        for (int d = 0; d < 128; ++d) acc = fmaf(pw[d] * sc[d], wo[(size_t)d * DM], acc);
        P.WO[(size_t)l * DM * DM + (size_t)n * DM + 512 + gc] = (bf16)f2bf(acc);
    }
    for (int row = gw; row < M; row += NGW) {
        const GAS f32x4* xr = (const GAS f32x4*)(P.x + (size_t)row * DM) + lane; const GAS f32x4* gr = (const GAS f32x4*)P.norm1_g + lane; float s = 0.f;
#pragma unroll
        for (int j = 0; j < 4; ++j) { const f32x4 v = xr[64 * j], gg = gr[64 * j]; s += (v.x * v.x + v.y * v.y) + (v.z * v.z + v.w * v.w);
            v2u o; o.x = pk2(v.x * gg.x, v.y * gg.y); o.y = pk2(v.z * gg.z, v.w * gg.w); *((GAS v2u*)(P.XB + (size_t)row * DM) + lane + 64 * j) = o; }
        s = wave_sum(s);
        if (lane < 4) *((GAS f32x4*)(P.SSQ + (size_t)row * NSSQ) + lane) = (f32x4){lane == 0 ? s : 0.f, 0.f, 0.f, 0.f};
    }
}
__device__ __forceinline__ void final_norm(float* outp, const float* fg, int vcu, int G, int wave, int lane) {
    const int gw = vcu * NWAVES + wave, NGW = G * NWAVES;
    for (int row = gw; row < M; row += NGW) {
        GAS f32x4* xr = (GAS f32x4*)(outp + (size_t)row * DM) + lane; const GAS f32x4* gr = (const GAS f32x4*)fg + lane;
        f32x4 v[4]; float s = 0.f;
#pragma unroll
        for (int j = 0; j < 4; ++j) { v[j] = xr[64 * j]; s += (v[j].x * v[j].x + v[j].y * v[j].y) + (v[j].z * v[j].z + v[j].w * v[j].w); }
        const float r = 1.0f / sqrtf(wave_sum(s) * (1.0f / DM) + EPS);
#pragma unroll
        for (int j = 0; j < 4; ++j) xr[64 * j] = v[j] * r * gr[64 * j];
    }
}

struct Args { const float* in[13]; float* out; unsigned char* ws; int ph_lo, ph_hi; };
typedef const __attribute__((address_space(4))) Args* kargs_t;
#define KARGS(A_) kargs_t A_ = (kargs_t)__builtin_amdgcn_kernarg_segment_ptr(); asm volatile("" : "+s"(A_))
__device__ __forceinline__ void fill_ptrs(Ptrs& P, kargs_t A) {
    unsigned char* ws = A->ws;
    P.x = A->in[0]; P.norm1_g = A->in[1]; P.w_in = A->in[2]; P.lam_qk = A->in[3]; P.subln_g = A->in[4]; P.pool_w = A->in[5]; P.pool_scale = A->in[6]; P.w_out = A->in[7];
    P.norm2_g = A->in[8]; P.w_gate = A->in[9]; P.w_up = A->in[10]; P.w_down = A->in[11]; P.final_g = A->in[12]; P.out = A->out;
    P.W1 = (bf16*)(ws + WS_W1); P.WO = (bf16*)(ws + WS_WO); P.WGU = (bf16*)(ws + WS_WGU); P.WD = (bf16*)(ws + WS_WD); P.XB = (bf16*)(ws + WS_XB);
    P.PROJ = (bf16*)(ws + WS_PROJ); P.MIX = (bf16*)(ws + WS_MIX); P.H = (bf16*)(ws + WS_H); P.SSQ = (float*)(ws + WS_SSQ);
}
__global__ void __launch_bounds__(NWAVES * 64, 2) mk_fwd(Args args) {
    extern __shared__ __attribute__((aligned(16))) unsigned char lds_raw[];
    LAS unsigned char* lds = (LAS unsigned char*)lds_raw;
    volatile LAS unsigned* MISC = (volatile LAS unsigned*)(lds + MISC_OFF);
    const int tid = threadIdx.x, lane = tid & 63, wave = __builtin_amdgcn_readfirstlane(tid >> 6);
    const int G = gridDim.x; const int bx = blockIdx.x; const int vcu = (G % 8 == 0) ? (bx % 8) * (G / 8) + bx / 8 : bx;
    for (int u = tid; u < (LDS_BYTES - LDSCTL_OFF) / 4; u += NWAVES * 64) ((LAS unsigned*)(lds + LDSCTL_OFF))[u] = 0u;
    __syncthreads();
    const int lo = args.ph_lo, hi = args.ph_hi;
    XcdBarrier bar; bar.bar = (unsigned*)(args.ws + WS_CTL) + CW_BAR; bar.x = 0; bar.st = nullptr;
    if (hi - lo > 1) bar = xcd_barrier_post((unsigned*)(args.ws + WS_CTL) + CW_BAR, MISC + 8);
#ifndef MK_EN
#define MK_EN 0xffu
#endif
#define IN(k) (lo <= (k) && (k) < hi)
#define SEAM(k) do { if (IN(k) && IN((k) + 1)) xcd_barrier(bar); } while (0)

    if (IN(0) && (MK_EN & 1u)) { KARGS(A); Ptrs P; fill_ptrs(P, A); p0_prologue(P, lds, vcu, G, wave, lane); SEAM(0); }

    for (int l = 0; l < DEPTH; ++l) {
        const int pb = 1 + 5 * l;
        if (IN(pb) && (MK_EN & 2u)) {
            KARGS(A); unsigned char* ws = A->ws;
            pg8::Gemm g{(const bf16*)(ws + WS_XB), (const bf16*)(ws + WS_W1) + (size_t)l * INW * DM, M, INW, DM}; pg8::StaticOrder S; S.init(M, INW, G, bx);
            pg8::EpiProj E{(bf16*)(ws + WS_PROJ), (const float*)(ws + WS_SSQ)};
            pg8::gemm_phase<pg8::EpiProj, pg8::StaticOrder, true, true>(lds + RING_OFF, g, S, E);
            SEAM(pb);
        }
        if (IN(pb + 1) && (MK_EN & 4u)) {
            KARGS(A); unsigned char* ws = A->ws;
            dattn::attn_pool_phase((char*)lds_raw + RING_OFF, (const bf16*)(ws + WS_PROJ), (bf16*)(ws + WS_MIX), A->in[3] + l * 256, l == 0 ? LAM0_0 : LAM0_1, A->in[4] + l * DV, vcu, G);
            SEAM(pb + 1);
        }
        if (IN(pb + 2) && (MK_EN & 8u)) {
            KARGS(A); unsigned char* ws = A->ws; float* out = A->out;
            pg8::Gemm g{(const bf16*)(ws + WS_MIX), (const bf16*)(ws + WS_WO) + (size_t)l * DM * DM, M, DM, DM}; pg8::StaticOrder S; S.init(M, DM, G, bx);
            pg8::EpiRes E{l == 0 ? A->in[0] : out, out, (bf16*)(ws + WS_XB), A->in[8] + l * DM, (float*)(ws + WS_SSQ)};
            pg8::gemm_phase<pg8::EpiRes, pg8::StaticOrder, true, true>(lds + RING_OFF, g, S, E);
            SEAM(pb + 2);
        }
        if (IN(pb + 3) && (MK_EN & 16u)) {
            KARGS(A); unsigned char* ws = A->ws;
            pg8::Gemm g{(const bf16*)(ws + WS_XB), (const bf16*)(ws + WS_WGU) + (size_t)l * NGU * DM, M, NGU, DM}; pg8::StaticOrder S; S.init(M, NGU, G, bx);
            pg8::EpiSwiglu E{(bf16*)(ws + WS_H), (const float*)(ws + WS_SSQ)};
            pg8::gemm_phase<pg8::EpiSwiglu, pg8::StaticOrder, true, true>(lds + RING_OFF, g, S, E);
            SEAM(pb + 3);
        }
        if (IN(pb + 4) && (MK_EN & 32u)) {
            KARGS(A); unsigned char* ws = A->ws; float* out = A->out;
            pg8::Gemm g{(const bf16*)(ws + WS_H), (const bf16*)(ws + WS_WD) + (size_t)l * DM * DFF, M, DM, DFF}; pg8::StaticOrder S; S.init(M, DM, G, bx);
            pg8::EpiRes E{out, out, (l + 1 < DEPTH) ? (bf16*)(ws + WS_XB) : nullptr, A->in[1] + (l + 1 < DEPTH ? (l + 1) * DM : 0), (float*)(ws + WS_SSQ)};
            pg8::gemm_phase<pg8::EpiRes, pg8::StaticOrder, true, true>(lds + RING_OFF, g, S, E);
            SEAM(pb + 4);
        }
    }
    if (IN(NPHASE - 1) && (MK_EN & 64u)) { KARGS(A); final_norm(A->out, A->in[12], vcu, G, wave, lane); }
#undef IN
#undef SEAM
}

#ifndef MK_ONE_LAUNCH
#define MK_ONE_LAUNCH 1
#endif
#ifndef MK_NAIVE_MASK
#define MK_NAIVE_MASK 0u
#endif
#if !MK_ONE_LAUNCH
constexpr size_t WS_LAM = 47 * MiB;
__global__ void __launch_bounds__(256) k_transpose(const float* __restrict__ W, int K, int N, bf16* __restrict__ WT, int ldk, int row_off, int mode) {
    __shared__ float scr_all[4][64 * 33];
    const int wave = threadIdx.x >> 6, lane = threadIdx.x & 63;
    float* scr = scr_all[wave];
    const int nblk = N / 32, nitems = (K / 64) * nblk;
    for (int item = blockIdx.x * 4 + wave; item < nitems; item += gridDim.x * 4) {
        const int kb = item / nblk, nb = item % nblk, k0 = 64 * kb, n0 = 32 * nb;
        for (int i = 0; i < 32; ++i) { const int kk = 2 * i + (lane >> 5); scr[kk * 33 + (lane & 31)] = W[(size_t)(k0 + kk) * N + n0 + (lane & 31)]; }
        __builtin_amdgcn_wave_barrier(); asm volatile("s_waitcnt lgkmcnt(0)" ::: "memory");
        const int c = lane & 7;
        const int rbase = (mode == 1) ? (256 * (n0 / 128) + (n0 % 128) + row_off) : (row_off + n0);
        for (int j = 0; j < 4; ++j) { const int n = (lane >> 3) + 8 * j; const float* s = scr + (8 * c) * 33 + n;
            uint4 o; o.x = pk2(s[0 * 33], s[1 * 33]); o.y = pk2(s[2 * 33], s[3 * 33]); o.z = pk2(s[4 * 33], s[5 * 33]); o.w = pk2(s[6 * 33], s[7 * 33]);
            *(uint4*)(WT + (size_t)(rbase + n) * ldk + k0 + 8 * c) = o; }
        asm volatile("s_waitcnt lgkmcnt(0)" ::: "memory"); __builtin_amdgcn_wave_barrier();
    }
}
__global__ void __launch_bounds__(256) k_fold_pool(const float* __restrict__ pool_w, const float* __restrict__ scale, const float* __restrict__ w_out, bf16* __restrict__ WoT) {
    const int idx = blockIdx.x * 256 + threadIdx.x;
    const int n = idx & 1023, gc = idx >> 10, g = gc >> 7, c = gc & 127;
    const float* pw = pool_w + ((size_t)g * 128 + c) * 128; const float* sc = scale + 128 * g; const float* wo = w_out + (size_t)(512 + 128 * g) * DM + n;
    float acc = 0.f;
    for (int d = 0; d < 128; ++d) acc = fmaf(pw[d] * sc[d], wo[(size_t)d * DM], acc);
    WoT[(size_t)n * DM + 512 + gc] = (bf16)f2bf(acc);
}
__global__ void k_lambda(const float* __restrict__ lam_qk, float* __restrict__ lam_out) {
    const int l = threadIdx.x; if (l >= DEPTH) return;
    const float* q = lam_qk + l * 256; float s1 = 0.f, s2 = 0.f;
    for (int i = 0; i < 64; ++i) { s1 += q[i] * q[64 + i]; s2 += q[128 + i] * q[192 + i]; }
    lam_out[l] = expf(s1) - expf(s2) + (l == 0 ? LAM0_0 : LAM0_1);
}
__global__ void __launch_bounds__(256) k_prep_x(const float* __restrict__ x, const float* __restrict__ g, bf16* __restrict__ XB, float* __restrict__ SSQ) {
    const int row = blockIdx.x * 4 + (threadIdx.x >> 6), lane = threadIdx.x & 63;
    const f32x4* xr = (const f32x4*)(x + (size_t)row * DM) + lane; const f32x4* gr = (const f32x4*)g + lane;
    float s = 0.f;
    for (int j = 0; j < 4; ++j) { const f32x4 v = xr[64 * j], gg = gr[64 * j]; s += (v.x * v.x + v.y * v.y) + (v.z * v.z + v.w * v.w);
        uint2 o; o.x = pk2(v.x * gg.x, v.y * gg.y); o.y = pk2(v.z * gg.z, v.w * gg.w); *((uint2*)(XB + (size_t)row * DM) + lane + 64 * j) = o; }
    for (int o = 1; o < 64; o <<= 1) s += __shfl_xor(s, o);
    if (lane < 4) *((f32x4*)(SSQ + (size_t)row * NSSQ) + lane) = (f32x4){lane == 0 ? s : 0.f, 0.f, 0.f, 0.f};
}
enum { EPI_PROJ = 0, EPI_RES = 1, EPI_SWIGLU = 2 };
struct EpiArgs { bf16* outb; float* outf; const float* base; const float* SSQ; int ldc; int pad; };
template <int EPI, int NB> __global__ void __launch_bounds__(256) k_gemm(const bf16* __restrict__ A, const bf16* __restrict__ Bt, int K, EpiArgs e) {
    const int lane = threadIdx.x & 63, w = threadIdx.x >> 6, fr = lane & 15, fq = lane >> 4;
    const int m0 = blockIdx.y * 128 + 64 * (w >> 1), n0 = blockIdx.x * (NB * 128) + 64 * (w & 1);
    f32x4 acc[NB][4][4];
    for (int g = 0; g < NB; ++g) for (int i = 0; i < 4; ++i) for (int j = 0; j < 4; ++j) acc[g][i][j] = (f32x4){0.f, 0.f, 0.f, 0.f};
    const bf16* ap = A + (size_t)(m0 + fr) * K + 8 * fq; const bf16* bp = Bt + (size_t)(n0 + fr) * K + 8 * fq;
    for (int k0 = 0; k0 < K; k0 += 32) {
        bf16x8 af[4], bfr[NB][4];
#pragma unroll
        for (int i = 0; i < 4; ++i) af[i] = *(const bf16x8*)(ap + (size_t)(16 * i) * K + k0);
#pragma unroll
        for (int g = 0; g < NB; ++g)
#pragma unroll
            for (int j = 0; j < 4; ++j) bfr[g][j] = *(const bf16x8*)(bp + (size_t)(128 * g + 16 * j) * K + k0);
#pragma unroll
        for (int g = 0; g < NB; ++g)
#pragma unroll
            for (int i = 0; i < 4; ++i)
#pragma unroll
                for (int j = 0; j < 4; ++j) acc[g][i][j] = __builtin_amdgcn_mfma_f32_16x16x32_bf16(bfr[g][j], af[i], acc[g][i][j], 0, 0, 0);
    }
#pragma unroll
    for (int i = 0; i < 4; ++i) {
        const int row = m0 + 16 * i + fr;
        if (EPI == EPI_PROJ) {
            const float r = pg8::rstd16(e.SSQ, row);
#pragma unroll
            for (int j = 0; j < 4; ++j) { const int col = n0 + 16 * j + 4 * fq; const float s = (col < ATTW) ? r * C2 : r; const f32x4 v = acc[0][i][j] * s;
                uint2 o; o.x = pk2(v.x, v.y); o.y = pk2(v.z, v.w); *(uint2*)(e.outb + (size_t)row * e.ldc + col) = o; }
        } else if (EPI == EPI_RES) {
#pragma unroll
            for (int j = 0; j < 4; ++j) { const int col = n0 + 16 * j + 4 * fq; const f32x4 b = *(const f32x4*)(e.base + (size_t)row * e.ldc + col);
                *(f32x4*)(e.outf + (size_t)row * e.ldc + col) = b + acc[0][i][j]; }
        } else {
            const float r = pg8::rstd16(e.SSQ, row);
#pragma unroll
            for (int j = 0; j < 4; ++j) { const int col = blockIdx.x * 128 + 64 * (w & 1) + 16 * j + 4 * fq;
                const f32x4 gt = acc[0][i][j] * r, up = acc[NB - 1][i][j] * r; f32x4 h;
                for (int q = 0; q < 4; ++q) h[q] = gt[q] / (1.0f + __expf(-gt[q])) * up[q];
                uint2 o; o.x = pk2(h.x, h.y); o.y = pk2(h.z, h.w); *(uint2*)(e.outb + (size_t)row * e.ldc + col) = o; }
        }
    }
}
__global__ void __launch_bounds__(128) k_attn_naive(const bf16* __restrict__ PROJ, bf16* __restrict__ MIX, const float* __restrict__ lamp, int layer, const float* __restrict__ subln_g, float one_minus_lam0) {
    __shared__ float s1[SEQ], s2[SEQ], qv[128], red[8];
    const int tid = threadIdx.x, qpos = blockIdx.x, h = blockIdx.y, b = blockIdx.z;
    const size_t row = (size_t)b * SEQ + qpos;
    qv[tid] = bf2f(PROJ[row * INW + h * 128 + tid]);
    __syncthreads();
    float m1 = -INFINITY, m2 = -INFINITY;
    for (int j = tid; j <= qpos; j += 128) {
        const bf16* kr = PROJ + ((size_t)b * SEQ + j) * INW + ATTW + h * 128; float a1 = 0.f, a2 = 0.f;
        for (int d = 0; d < 64; ++d) { a1 += qv[d] * bf2f(kr[d]); a2 += qv[64 + d] * bf2f(kr[64 + d]); }
        s1[j] = a1; s2[j] = a2; m1 = fmaxf(m1, a1); m2 = fmaxf(m2, a2);
    }
    for (int o = 1; o < 64; o <<= 1) { m1 = fmaxf(m1, __shfl_xor(m1, o)); m2 = fmaxf(m2, __shfl_xor(m2, o)); }
    if ((tid & 63) == 0) { red[tid >> 6] = m1; red[2 + (tid >> 6)] = m2; }
    __syncthreads();
    m1 = fmaxf(red[0], red[1]); m2 = fmaxf(red[2], red[3]);
    float l1 = 0.f, l2 = 0.f;
    for (int j = tid; j <= qpos; j += 128) { const float p1 = exp2f(s1[j] - m1), p2 = exp2f(s2[j] - m2); s1[j] = p1; s2[j] = p2; l1 += p1; l2 += p2; }
    for (int o = 1; o < 64; o <<= 1) { l1 += __shfl_xor(l1, o); l2 += __shfl_xor(l2, o); }
    if ((tid & 63) == 0) { red[4 + (tid >> 6)] = l1; red[6 + (tid >> 6)] = l2; }
    __syncthreads();
    l1 = red[4] + red[5]; l2 = red[6] + red[7];
    float o1 = 0.f, o2 = 0.f;
    const bf16* vp = PROJ + (size_t)b * SEQ * INW + 2 * ATTW + h * 128 + tid;
    for (int j = 0; j <= qpos; ++j) { const float v = bf2f(vp[(size_t)j * INW]); o1 = fmaf(s1[j], v, o1); o2 = fmaf(s2[j], v, o2); }
    const float lam = lamp[layer];
    const float a = o1 / l1 - lam * (o2 / l2);
    float ss = a * a;
    for (int o = 1; o < 64; o <<= 1) ss += __shfl_xor(ss, o);
    __syncthreads();
    if ((tid & 63) == 0) red[tid >> 6] = ss;
    __syncthreads();
    ss = red[0] + red[1];
    const float y = a * (1.0f / sqrtf(ss * (1.0f / DV) + EPS)) * subln_g[tid] * one_minus_lam0;
    MIX[row * DM + h * 128 + tid] = (bf16)f2bf(y);
}
__global__ void __launch_bounds__(256) k_pool_naive(const bf16* __restrict__ PROJ, bf16* __restrict__ MIX) {
    const int idx = blockIdx.x * 256 + threadIdx.x, c = idx & 511, row = idx >> 9, t = row & (SEQ - 1), g = c >> 7, w = 2 << g;
    const int n = (t + 1 < w) ? (t + 1) : w;
    const bf16* up = PROJ + (size_t)row * INW + 3 * ATTW + c; float s = 0.f;
    for (int i = 0; i < n; ++i) s += bf2f(*(up - (size_t)i * INW));
    MIX[(size_t)row * DM + ATTW + c] = (bf16)f2bf(s / (float)n - bf2f(*up));
}
__global__ void __launch_bounds__(256) k_final(float* __restrict__ x, const float* __restrict__ g) {
    const int row = blockIdx.x * 4 + (threadIdx.x >> 6), lane = threadIdx.x & 63;
    f32x4* xr = (f32x4*)(x + (size_t)row * DM) + lane; const f32x4* gr = (const f32x4*)g + lane;
    f32x4 v[4]; float s = 0.f;
    for (int j = 0; j < 4; ++j) { v[j] = xr[64 * j]; s += (v[j].x * v[j].x + v[j].y * v[j].y) + (v[j].z * v[j].z + v[j].w * v[j].w); }
    for (int o = 1; o < 64; o <<= 1) s += __shfl_xor(s, o);
    const float r = 1.0f / sqrtf(s * (1.0f / DM) + EPS);
    for (int j = 0; j < 4; ++j) xr[64 * j] = v[j] * r * gr[64 * j];
}
static void naive_phase(int p, const Ptrs& P, unsigned char* ws, hipStream_t stream) {
    float* LAM = (float*)(ws + WS_LAM);
    if (p == 0) {
        for (int l = 0; l < DEPTH; ++l) {
            k_transpose<<<512, 256, 0, stream>>>(P.w_in + (size_t)l * DM * INW, DM, INW, P.W1 + (size_t)l * INW * DM, DM, 0, 0);
            k_transpose<<<512, 256, 0, stream>>>(P.w_out + (size_t)l * DM * DM, ATTW, DM, P.WO + (size_t)l * DM * DM, DM, 0, 0);
            k_transpose<<<512, 256, 0, stream>>>(P.w_gate + (size_t)l * DM * DFF, DM, DFF, P.WGU + (size_t)l * NGU * DM, DM, 0, 1);
            k_transpose<<<512, 256, 0, stream>>>(P.w_up + (size_t)l * DM * DFF, DM, DFF, P.WGU + (size_t)l * NGU * DM, DM, 128, 1);
            k_transpose<<<512, 256, 0, stream>>>(P.w_down + (size_t)l * DFF * DM, DFF, DM, P.WD + (size_t)l * DM * DFF, DFF, 0, 0);
            k_fold_pool<<<512 * 1024 / 256, 256, 0, stream>>>(P.pool_w + (size_t)l * 4 * 128 * 128, P.pool_scale + l * 512, P.w_out + (size_t)l * DM * DM, P.WO + (size_t)l * DM * DM);
        }
        k_prep_x<<<M / 4, 256, 0, stream>>>(P.x, P.norm1_g, P.XB, P.SSQ);
        return;
    }
    if (p == NPHASE - 1) { k_final<<<M / 4, 256, 0, stream>>>(P.out, P.final_g); return; }
    const int l = (p - 1) / 5, k = (p - 1) % 5;
    if (k == 0) { EpiArgs e{P.PROJ, nullptr, nullptr, P.SSQ, INW, 0}; k_gemm<EPI_PROJ, 1><<<dim3(INW / 128, M / 128), 256, 0, stream>>>(P.XB, P.W1 + (size_t)l * INW * DM, DM, e); }
    if (k == 1) { k_lambda<<<1, 64, 0, stream>>>(P.lam_qk, LAM);
        k_attn_naive<<<dim3(SEQ, NH, BATCH), 128, 0, stream>>>(P.PROJ, P.MIX, LAM, l, P.subln_g + l * DV, 1.0f - (l == 0 ? LAM0_0 : LAM0_1));
        k_pool_naive<<<M * 512 / 256, 256, 0, stream>>>(P.PROJ, P.MIX); }
    if (k == 2) { EpiArgs e{nullptr, P.out, l == 0 ? P.x : P.out, nullptr, DM, 0}; k_gemm<EPI_RES, 1><<<dim3(DM / 128, M / 128), 256, 0, stream>>>(P.MIX, P.WO + (size_t)l * DM * DM, DM, e);
        k_prep_x<<<M / 4, 256, 0, stream>>>(P.out, P.norm2_g + l * DM, P.XB, P.SSQ); }
    if (k == 3) { EpiArgs e{P.H, nullptr, nullptr, P.SSQ, DFF, 0}; k_gemm<EPI_SWIGLU, 2><<<dim3(DFF / 128, M / 128), 256, 0, stream>>>(P.XB, P.WGU + (size_t)l * NGU * DM, DM, e); }
    if (k == 4) { EpiArgs e{nullptr, P.out, P.out, nullptr, DM, 0}; k_gemm<EPI_RES, 1><<<dim3(DM / 128, M / 128), 256, 0, stream>>>(P.H, P.WD + (size_t)l * DM * DFF, DFF, e);
        if (l + 1 < DEPTH) k_prep_x<<<M / 4, 256, 0, stream>>>(P.out, P.norm1_g + (l + 1) * DM, P.XB, P.SSQ); }
}
#endif

extern "C" void kernel_launch(void* const* d_in, const int* in_sizes, int n_in, void* d_out, int out_size, void* d_ws, size_t ws_size, hipStream_t stream) {
    static int grid = 0;
    if (grid == 0) {
        if (n_in != 13 || in_sizes[0] != M * DM || out_size != M * DM || ws_size < WS_END) { fprintf(stderr, "kernel_launch: unexpected shapes (n_in %d, ws %zu); nothing launched\n", n_in, ws_size); grid = -1; return; }
        int dev = 0, cus = 0, per_cu = 0;
        if (hipGetDevice(&dev) != hipSuccess || hipDeviceGetAttribute(&cus, hipDeviceAttributeMultiprocessorCount, dev) != hipSuccess) { fprintf(stderr, "kernel_launch: device query failed\n"); grid = -1; return; }
        if (hipFuncSetAttribute((const void*)mk_fwd, hipFuncAttributeMaxDynamicSharedMemorySize, LDS_BYTES) != hipSuccess) { fprintf(stderr, "kernel_launch: hipFuncSetAttribute failed\n"); grid = -1; return; }
        if (hipOccupancyMaxActiveBlocksPerMultiprocessor(&per_cu, (const void*)mk_fwd, NWAVES * 64, LDS_BYTES) != hipSuccess || per_cu < 1)
            fprintf(stderr, "kernel_launch: note: occupancy query reports %d workgroups per CU\n", per_cu);
        (void)hipGetLastError();
        grid = cus;
    }
    if (grid < 0) return;
    if (hipMemsetAsync((char*)d_ws + WS_CTL, 0, CTL_ZERO_BYTES, stream) != hipSuccess) { fprintf(stderr, "kernel_launch: hipMemsetAsync failed\n"); return; }
    Args a{};
    for (int i = 0; i < 13; ++i) a.in[i] = (const float*)d_in[i];
    a.out = (float*)d_out; a.ws = (unsigned char*)d_ws;
#if MK_ONE_LAUNCH
    a.ph_lo = 0; a.ph_hi = NPHASE;
    hipLaunchKernelGGL(mk_fwd, dim3(grid), dim3(NWAVES * 64), LDS_BYTES, stream, a);
#else
    unsigned char* ws = (unsigned char*)d_ws;
    Ptrs P;
    P.x = a.in[0]; P.norm1_g = a.in[1]; P.w_in = a.in[2]; P.lam_qk = a.in[3]; P.subln_g = a.in[4]; P.pool_w = a.in[5]; P.pool_scale = a.in[6]; P.w_out = a.in[7];
    P.norm2_g = a.in[8]; P.w_gate = a.in[9]; P.w_up = a.in[10]; P.w_down = a.in[11]; P.final_g = a.in[12]; P.out = a.out;
    P.W1 = (bf16*)(ws + WS_W1); P.WO = (bf16*)(ws + WS_WO); P.WGU = (bf16*)(ws + WS_WGU); P.WD = (bf16*)(ws + WS_WD); P.XB = (bf16*)(ws + WS_XB);
    P.PROJ = (bf16*)(ws + WS_PROJ); P.MIX = (bf16*)(ws + WS_MIX); P.H = (bf16*)(ws + WS_H); P.SSQ = (float*)(ws + WS_SSQ);
    for (int p = 0; p < NPHASE; ++p) {
        if ((MK_NAIVE_MASK >> p) & 1u) { naive_phase(p, P, ws, stream); continue; }
        a.ph_lo = p; a.ph_hi = p + 1;
        hipLaunchKernelGGL(mk_fwd, dim3(grid), dim3(NWAVES * 64), LDS_BYTES, stream, a);
    }
#endif
    const hipError_t le = hipPeekAtLastError();
    if (le != hipSuccess) fprintf(stderr, "kernel_launch: launch failed: %s (grid %d)\n", hipGetErrorName(le), grid);
}
```

```cpp
#include <hip/hip_runtime.h>
#include <cstdio>
#include <cstdint>
#include <cmath>

constexpr int BATCH = 8, SEQ = 2048, DM = 1024, DEPTH = 2, M = BATCH * SEQ;
constexpr int NH = 4, DV = 128, ATTW = 512, INW = 2048, DFF = 2816, NGU = 2 * DFF;
constexpr float EPS = 1e-5f;
constexpr float C2 = 0.125f * 1.4426950408889634f;
constexpr float LAM0_0 = 0.2f, LAM0_1 = 0.35550906759096926f;
constexpr int NSSQ = 16;

#define MK_ONE_LAUNCH 1
#define MK_NAIVE_MASK 0u
namespace pg8 {
#define PG8_LAS __attribute__((address_space(3)))
typedef unsigned short bf16_t;
typedef short bf16x8 __attribute__((ext_vector_type(8)));
typedef float f32x4 __attribute__((ext_vector_type(4)));
typedef unsigned u32x4 __attribute__((ext_vector_type(4)));
constexpr int BM = 256, BK = 64, HALF = 128, HTB = HALF * BK * 2  , STAGE_BYTES = 8 * HTB, NXCD = 8, WGM = 8;

__host__ __device__ __forceinline__ int lds_byte(int r, int c) { const int st = (r >> 4) * 2 + (c >> 5), rr = r & 15, cc = c & 31, ob = rr * 64 + cc * 2; return st * 1024 + (ob ^ (((ob >> 9) & 1) << 5)); }
__host__ __device__ __forceinline__ void stage_rc(int b, int& R, int& C) { const int st = b / 1024, sb = b % 1024, swz = sb ^ (((sb >> 9) & 1) << 5); R = (st >> 1) * 16 + swz / 64; C = (st & 1) * 32 + (swz % 64) / 2; }
__host__ __device__ __forceinline__ int perm32(int rho) { const int n = rho >> 4, i = rho & 15; return 8 * (i >> 2) + 4 * n + (i & 3); }

struct Unit { int pm, pn; };
struct Gemm { const bf16_t* A; const bf16_t* Bt; int M, N, K; };

struct StaticOrder {
    int nM, nN, nwg, G, c;
    __host__ __device__ void init(int M, int N, int G_, int c_) { nM = M / BM; nN = N / BM; nwg = nM * nN; G = G_; c = c_; }
    __host__ __device__ bool next(int i, Unit& u) const {
        const long L = (long)i * G + c; if (L >= nwg) return false;
        int wgid = (int)L; { const int q = nwg / NXCD, r = nwg % NXCD, xcd = wgid % NXCD, off = wgid / NXCD; wgid = (xcd < r ? xcd * (q + 1) : r * (q + 1) + (xcd - r) * q) + off; }
        const int nig = WGM * nN, gid = wgid / nig, fm = gid * WGM, gsz = (nM - fm) < WGM ? (nM - fm) : WGM;
        u.pm = fm + ((wgid % nig) % gsz); u.pn = (wgid % nig) / gsz; return true;
    }
    __device__ __forceinline__ void a_ready(const Unit&) const {}
    __device__ __forceinline__ void done(const Unit&) const {}
};

__device__ __forceinline__ unsigned cvt_pk_bf16(float lo, float hi) { unsigned r; asm volatile("v_cvt_pk_bf16_f32 %0, %1, %2" : "=v"(r) : "v"(lo), "v"(hi)); return r; }
__device__ __forceinline__ float rstd16(const float* SSQ, int row) {
    const f32x4* p = (const f32x4*)(SSQ + (size_t)row * NSSQ); const f32x4 a = p[0], b = p[1], c = p[2], d = p[3];
    const float s = ((a[0] + a[1]) + (a[2] + a[3])) + ((b[0] + b[1]) + (b[2] + b[3])) + ((c[0] + c[1]) + (c[2] + c[3])) + ((d[0] + d[1]) + (d[2] + d[3]));
    return 1.0f / sqrtf(s * (1.0f / DM) + EPS);
}
struct EpiProj {
    static constexpr bool PERM = true, AFTER_DRAIN = false;
    bf16_t* O; const float* SSQ;
    __device__ __forceinline__ void operator()(const f32x4 (&acc)[2][2][4][2], const Unit& u, int wr, int wc, int fr, int fq) const {
        const int row0 = u.pm * BM + wr * 64 + fr, col0 = u.pn * BM + wc * 32 + 8 * fq;
        const float qs = (u.pn < 2) ? C2 : 1.0f;
#pragma unroll
        for (int ai = 0; ai < 2; ++ai)
#pragma unroll
            for (int m = 0; m < 4; ++m) { const int row = row0 + ai * HALF + m * 16; const float r = rstd16(SSQ, row) * qs; bf16_t* rowp = O + (size_t)row * INW + col0;
#pragma unroll
                for (int bj = 0; bj < 2; ++bj) { const f32x4 v0 = acc[ai][bj][m][0] * r, v1 = acc[ai][bj][m][1] * r;
                    u32x4 w; w.x = cvt_pk_bf16(v0[0], v0[1]); w.y = cvt_pk_bf16(v0[2], v0[3]); w.z = cvt_pk_bf16(v1[0], v1[1]); w.w = cvt_pk_bf16(v1[2], v1[3]);
                    *(u32x4*)(rowp + bj * HALF) = w; } }
    }
};
struct EpiSwiglu {
    static constexpr bool PERM = true, AFTER_DRAIN = false;
    bf16_t* O; const float* SSQ;
    __device__ __forceinline__ void operator()(const f32x4 (&acc)[2][2][4][2], const Unit& u, int wr, int wc, int fr, int fq) const {
        const int row0 = u.pm * BM + wr * 64 + fr, col0 = u.pn * HALF + wc * 32 + 8 * fq;
#pragma unroll
        for (int ai = 0; ai < 2; ++ai)
#pragma unroll
            for (int m = 0; m < 4; ++m) { const int row = row0 + ai * HALF + m * 16; const float r = rstd16(SSQ, row); float hv[8];
#pragma unroll
                for (int n = 0; n < 2; ++n)
#pragma unroll
                    for (int q = 0; q < 4; ++q) { const float g = acc[ai][0][m][n][q] * r, up = acc[ai][1][m][n][q] * r;
                        hv[4 * n + q] = g * __builtin_amdgcn_rcpf(1.0f + __builtin_amdgcn_exp2f(-1.4426950408889634f * g)) * up; }
                u32x4 w; w.x = cvt_pk_bf16(hv[0], hv[1]); w.y = cvt_pk_bf16(hv[2], hv[3]); w.z = cvt_pk_bf16(hv[4], hv[5]); w.w = cvt_pk_bf16(hv[6], hv[7]);
                *(u32x4*)(O + (size_t)row * DFF + col0) = w; }
    }
};
struct EpiRes {
    static constexpr bool PERM = true, AFTER_DRAIN = false;
    const float* base; float* out; bf16_t* XB; const float* gain; float* SSQ;
    __device__ __forceinline__ void operator()(const f32x4 (&acc)[2][2][4][2], const Unit& u, int wr, int wc, int fr, int fq) const {
        const int row0 = u.pm * BM + wr * 64 + fr, col0 = u.pn * BM + wc * 32 + 8 * fq;
        f32x4 gv[2][2];
#pragma unroll
        for (int bj = 0; bj < 2; ++bj)
#pragma unroll
            for (int n = 0; n < 2; ++n) gv[bj][n] = XB ? *(const f32x4*)(gain + col0 + bj * HALF + 4 * n) : (f32x4){0.f, 0.f, 0.f, 0.f};
#pragma unroll
        for (int ai = 0; ai < 2; ++ai)
#pragma unroll
            for (int m = 0; m < 4; ++m) { const int row = row0 + ai * HALF + m * 16; const size_t off = (size_t)row * DM + col0; float ss = 0.f;
#pragma unroll
                for (int bj = 0; bj < 2; ++bj) { f32x4 x0 = *(const f32x4*)(base + off + bj * HALF), x1 = *(const f32x4*)(base + off + bj * HALF + 4);
                    x0 += acc[ai][bj][m][0]; x1 += acc[ai][bj][m][1];
                    *(f32x4*)(out + off + bj * HALF) = x0; *(f32x4*)(out + off + bj * HALF + 4) = x1;
                    ss += ((x0[0] * x0[0] + x0[1] * x0[1]) + (x0[2] * x0[2] + x0[3] * x0[3])) + ((x1[0] * x1[0] + x1[1] * x1[1]) + (x1[2] * x1[2] + x1[3] * x1[3]));
                    if (XB) { const f32x4 y0 = x0 * gv[bj][0], y1 = x1 * gv[bj][1];
                        u32x4 w; w.x = cvt_pk_bf16(y0[0], y0[1]); w.y = cvt_pk_bf16(y0[2], y0[3]); w.z = cvt_pk_bf16(y1[0], y1[1]); w.w = cvt_pk_bf16(y1[2], y1[3]);
                        *(u32x4*)(XB + off + bj * HALF) = w; } }
                ss += __shfl_xor(ss, 16); ss += __shfl_xor(ss, 32);
                if (fq == 0) SSQ[(size_t)row * NSSQ + 4 * u.pn + wc] = ss;
                asm volatile("" ::: "memory"); }
    }
};

template <class Epi, class Sched, bool ALIGN_EPI = false, bool SP2 = false>
__device__ __forceinline__ void gemm_phase(PG8_LAS unsigned char* lds, const Gemm g, const Sched& S, const Epi& E) {
    int tid_o = threadIdx.x; asm volatile("" : "+v"(tid_o));
    const int tid = tid_o, wid = __builtin_amdgcn_readfirstlane(tid >> 6), lane = tid & 63, wr = wid >> 2, wc = wid & 3, fr = lane & 15, fq = lane >> 4;
    const int K = g.K, nt = K / BK;
    unsigned voffA[2], voffB[2];
#pragma unroll
    for (int i = 0; i < 2; ++i) { int R, C; stage_rc(tid * 16 + i * 8192, R, C); const int Rb = Epi::PERM ? ((R & ~31) + perm32(R & 31)) : R;
        voffA[i] = (unsigned)(R * K + C) * 2u; voffB[i] = (unsigned)(Rb * K + C) * 2u; }
    const size_t kstep = (size_t)(BK * 2);
    const size_t hstep = (size_t)HALF * K * 2;
    const size_t tstep = 2 * hstep;
    const unsigned ldsw = (unsigned)wid * 1024u;
    const int aoff = lds_byte(wr * 64 + fr, fq * 8), boff = lds_byte(wc * 32 + fr, fq * 8);
#define PG8_SA(b, h) (((b) * 2 + (h)) * HTB)
#define PG8_SB(b, h) ((4 + (b) * 2 + (h)) * HTB)
#define PG8_STAGE(bufoff, gbase, voff) do { _Pragma("unroll") for (int _i = 0; _i < 2; ++_i) \
        __builtin_amdgcn_global_load_lds((const unsigned*)((const char*)(gbase) + (voff)[_i]), (PG8_LAS unsigned*)(lds + (bufoff) + ldsw + _i * 8192), 16, 0, 0); } while (0)
#define PG8_LDA(dst, b, h) do { _Pragma("unroll") for (int m = 0; m < 4; ++m) _Pragma("unroll") for (int k = 0; k < 2; ++k) dst[m][k] = *(const PG8_LAS bf16x8*)(lds + PG8_SA(b, h) + aoff + m * 2048 + k * 1024); } while (0)
#define PG8_LDB(dst, b, h) do { _Pragma("unroll") for (int n = 0; n < 2; ++n) _Pragma("unroll") for (int k = 0; k < 2; ++k) dst[n][k] = *(const PG8_LAS bf16x8*)(lds + PG8_SB(b, h) + boff + n * 2048 + k * 1024); } while (0)
#define PG8_MMA(ai, bj, At, Bt) do { __builtin_amdgcn_s_setprio(1); _Pragma("unroll") for (int m = 0; m < 4; ++m) _Pragma("unroll") for (int n = 0; n < 2; ++n) _Pragma("unroll") for (int k = 0; k < 2; ++k) \
        acc[ai][bj][m][n] = __builtin_amdgcn_mfma_f32_16x16x32_bf16(Bt[n][k], At[m][k], acc[ai][bj][m][n], 0, 0, 0); __builtin_amdgcn_s_setprio(0); } while (0)
#define PG8_WAIT_V(n) asm volatile("s_waitcnt vmcnt(" #n ")" ::: "memory")
#define PG8_WAIT_L(n) asm volatile("s_waitcnt lgkmcnt(" #n ")" ::: "memory")
#define PG8_BAR __builtin_amdgcn_s_barrier()
#define PG8_SCHED __builtin_amdgcn_sched_barrier(0)
    Unit cur, nxt; int ui = 0;
    if (!S.next(0, cur)) return;
    f32x4 acc[2][2][4][2];
#pragma unroll
    for (int a = 0; a < 2; ++a)
#pragma unroll
        for (int b = 0; b < 2; ++b)
#pragma unroll
            for (int m = 0; m < 4; ++m)
#pragma unroll
                for (int n = 0; n < 2; ++n) acc[a][b][m][n] = (f32x4){0.f, 0.f, 0.f, 0.f};
    bf16x8 At[4][2], B0[2][2], B1[2][2];
    const char* cA = (const char*)g.A + (size_t)cur.pm * tstep; const char* cB = (const char*)g.Bt + (size_t)cur.pn * tstep;
    S.a_ready(cur);
    if constexpr (SP2) {
        PG8_STAGE(PG8_SB(0, 0), cB, voffB); PG8_STAGE(PG8_SB(0, 1), cB + hstep, voffB); PG8_STAGE(PG8_SA(0, 0), cA, voffA); PG8_STAGE(PG8_SA(0, 1), cA + hstep, voffA);
        if (wr == 1) PG8_BAR;
        PG8_WAIT_V(2); PG8_BAR;
        PG8_STAGE(PG8_SB(1, 0), cB + kstep, voffB); PG8_STAGE(PG8_SA(1, 0), cA + kstep, voffA); PG8_STAGE(PG8_SB(1, 1), cB + hstep + kstep, voffB);
        PG8_WAIT_V(6); PG8_BAR;
    } else {
        PG8_STAGE(PG8_SB(0, 0), cB, voffB); PG8_STAGE(PG8_SA(0, 0), cA, voffA); PG8_STAGE(PG8_SB(0, 1), cB + hstep, voffB); PG8_STAGE(PG8_SA(0, 1), cA + hstep, voffA);
        if (wr == 1) PG8_BAR;
        PG8_WAIT_V(4); PG8_BAR;
        PG8_STAGE(PG8_SB(1, 0), cB + kstep, voffB); PG8_STAGE(PG8_SA(1, 0), cA + kstep, voffA); PG8_STAGE(PG8_SB(1, 1), cB + hstep + kstep, voffB);
        PG8_WAIT_V(6); PG8_BAR;
    }
    for (;;) {
        const bool has_next = S.next(ui + 1, nxt);
        const char* nA = has_next ? (const char*)g.A + (size_t)nxt.pm * tstep : cA; const char* nB = has_next ? (const char*)g.Bt + (size_t)nxt.pn * tstep : cB;
        for (int t = 0; t < nt; t += 2) {
            const bool last = (t == nt - 2);
            const char* a1 = cA + (size_t)(t + 1) * kstep;
            const char* a2 = last ? nA : cA + (size_t)(t + 2) * kstep; const char* b2 = last ? nB : cB + (size_t)(t + 2) * kstep;
            const char* a3 = a2 + kstep; const char* b3 = b2 + kstep;
            if (last && has_next) S.a_ready(nxt);
            if constexpr (SP2) {
            PG8_LDB(B0, 0, 0); PG8_LDB(B1, 0, 1); PG8_SCHED; PG8_LDA(At, 0, 0); PG8_STAGE(PG8_SA(1, 1), a1 + hstep, voffA);
            PG8_WAIT_V(8); PG8_WAIT_L(0); PG8_BAR; PG8_MMA(0, 0, At, B0); PG8_MMA(0, 1, At, B1); PG8_BAR; PG8_SCHED;
            PG8_LDA(At, 0, 1); PG8_STAGE(PG8_SB(0, 0), b2, voffB); PG8_STAGE(PG8_SB(0, 1), b2 + hstep, voffB); PG8_STAGE(PG8_SA(0, 0), a2, voffA);
            PG8_WAIT_V(8); PG8_WAIT_L(0); PG8_BAR; PG8_MMA(1, 0, At, B0); PG8_MMA(1, 1, At, B1); PG8_BAR; PG8_SCHED;
            PG8_LDB(B0, 1, 0); PG8_LDB(B1, 1, 1); PG8_SCHED; PG8_LDA(At, 1, 0); PG8_STAGE(PG8_SA(0, 1), a2 + hstep, voffA);
            PG8_WAIT_V(8); PG8_WAIT_L(0); PG8_BAR; PG8_MMA(0, 0, At, B0); PG8_MMA(0, 1, At, B1); PG8_BAR; PG8_SCHED;
            PG8_LDA(At, 1, 1); PG8_STAGE(PG8_SB(1, 0), b3, voffB); PG8_STAGE(PG8_SB(1, 1), b3 + hstep, voffB); PG8_STAGE(PG8_SA(1, 0), a3, voffA);
            PG8_WAIT_V(8); PG8_WAIT_L(0); PG8_BAR; PG8_MMA(1, 0, At, B0); PG8_MMA(1, 1, At, B1); PG8_BAR; PG8_SCHED;
            } else {
            PG8_LDB(B0, 0, 0); PG8_SCHED; PG8_LDA(At, 0, 0); PG8_STAGE(PG8_SA(1, 1), a1 + hstep, voffA);
            PG8_WAIT_L(8); PG8_BAR; PG8_WAIT_L(0); PG8_MMA(0, 0, At, B0); PG8_BAR; PG8_SCHED;
            PG8_LDB(B1, 0, 1); PG8_STAGE(PG8_SB(0, 0), b2, voffB);
            PG8_BAR; PG8_WAIT_L(0); PG8_MMA(0, 1, At, B1); PG8_BAR;
            PG8_LDA(At, 0, 1); PG8_STAGE(PG8_SA(0, 0), a2, voffA);
            PG8_BAR; PG8_WAIT_L(0); PG8_MMA(1, 0, At, B0); PG8_BAR; PG8_SCHED;
            PG8_STAGE(PG8_SB(0, 1), b2 + hstep, voffB);
            PG8_WAIT_V(6); PG8_BAR; PG8_MMA(1, 1, At, B1); PG8_BAR;
            PG8_LDB(B0, 1, 0); PG8_SCHED; PG8_LDA(At, 1, 0); PG8_STAGE(PG8_SA(0, 1), a2 + hstep, voffA);
            PG8_WAIT_L(8); PG8_BAR; PG8_WAIT_L(0); PG8_MMA(0, 0, At, B0); PG8_BAR; PG8_SCHED;
            PG8_LDB(B1, 1, 1); PG8_STAGE(PG8_SB(1, 0), b3, voffB);
            PG8_BAR; PG8_WAIT_L(0); PG8_MMA(0, 1, At, B1); PG8_BAR;
            PG8_LDA(At, 1, 1); PG8_STAGE(PG8_SA(1, 0), a3, voffA);
            PG8_BAR; PG8_WAIT_L(0); PG8_MMA(1, 0, At, B0); PG8_BAR; PG8_SCHED;
            PG8_STAGE(PG8_SB(1, 1), b3 + hstep, voffB);
            PG8_WAIT_V(6); PG8_BAR; PG8_MMA(1, 1, At, B1); PG8_BAR;
            }
        }
        if constexpr (ALIGN_EPI) { if (wr == 0) PG8_BAR; }
        if constexpr (!Epi::AFTER_DRAIN) { E(acc, cur, wr, wc, fr, fq); S.done(cur); }
        if (!has_next) break;
#pragma unroll
        for (int a = 0; a < 2; ++a)
#pragma unroll
            for (int b = 0; b < 2; ++b)
#pragma unroll
                for (int m = 0; m < 4; ++m)
#pragma unroll
                    for (int n = 0; n < 2; ++n) acc[a][b][m][n] = (f32x4){0.f, 0.f, 0.f, 0.f};
        cur = nxt; cA = nA; cB = nB; ++ui;
        if constexpr (ALIGN_EPI) { if (wr == 1) PG8_BAR; }
    }
    PG8_WAIT_V(0);
    if constexpr (!ALIGN_EPI) { if (wr == 0) PG8_BAR; }
    PG8_BAR;
    if constexpr (Epi::AFTER_DRAIN) { E.fused(acc, cur, wr, wc, fr, fq, lds, wid, lane); S.done(cur); }
#undef PG8_SA
#undef PG8_SB
#undef PG8_STAGE
#undef PG8_LDA
#undef PG8_LDB
#undef PG8_MMA
#undef PG8_WAIT_V
#undef PG8_WAIT_L
#undef PG8_BAR
#undef PG8_SCHED
}
}
namespace dattn {
typedef unsigned short bf16_t;
typedef short bf16x8 __attribute__((ext_vector_type(8)));
typedef short s16x4 __attribute__((ext_vector_type(4)));
typedef float f32x16 __attribute__((ext_vector_type(16)));
typedef float f32x4 __attribute__((ext_vector_type(4)));
typedef unsigned u32x4 __attribute__((ext_vector_type(4)));
typedef short v4i16_t __attribute__((ext_vector_type(4)));
#define DA_LAS __attribute__((address_space(3)))
typedef DA_LAS const char* lds_cptr;
constexpr int QB = 128, KVBLK = 64, PITCH = INW, NSLOT = 3, SLOTB = 16384;
constexpr int LDS_K = 0, LDS_V = NSLOT * SLOTB, LDS_WS = 2 * NSLOT * SLOTB, LDS_BYTES = LDS_WS + 8 * 256;
constexpr int LDS_XCH = 0;
constexpr float THR = 6.0f;
__device__ __forceinline__ int crow(int r, int hi) { return (r & 3) + 8 * (r >> 2) + 4 * hi; }
__device__ __forceinline__ void glds16(const void* gsrc, unsigned lds_dst) { unsigned keep;
    asm volatile("s_mov_b32 %0, m0\n\ts_mov_b32 m0, %2\n\ts_nop 0\n\tglobal_load_lds_dwordx4 %1, off\n\ts_mov_b32 m0, %0" : "=&s"(keep) : "v"(gsrc), "s"(lds_dst) : "memory"); }
typedef float f32x2_t __attribute__((ext_vector_type(2))); typedef __bf16 bf16x2_t __attribute__((ext_vector_type(2)));
__device__ __forceinline__ unsigned cvtpk_s(float lo, float hi) { f32x2_t v = {lo, hi}; bf16x2_t b = __builtin_convertvector(v, bf16x2_t); return __builtin_bit_cast(unsigned, b); }
__device__ __forceinline__ s16x4 vtr(lds_cptr p) { return __builtin_bit_cast(s16x4, __builtin_amdgcn_ds_read_tr16_b64_v4i16((DA_LAS v4i16_t*)p)); }
#define DA_WAIT_BAR(N) asm volatile("s_waitcnt vmcnt(" #N ") lgkmcnt(0)\n\ts_barrier" ::: "memory")
#define DA_MFMA(a, b, c) __builtin_amdgcn_mfma_f32_32x32x16_bf16(a, b, c, 0, 0, 0)

__device__ __forceinline__ void attn_unit(int b, int h, int qb, const bf16_t* PROJ, bf16_t* MIX, float lam, const float* sg, float oml0, char* shm) {
    int tid_o = threadIdx.x; asm volatile("" : "+v"(tid_o));
    const int tid = tid_o, lane = tid & 63, r32 = lane & 31, hi = lane >> 5;
    const int wid = __builtin_amdgcn_readfirstlane(tid >> 6), c = wid >> 2, wq = wid & 3;
    const long rowbase = (long)b * SEQ; const int q0 = qb * QB;
    const bf16_t* Qw = PROJ + (rowbase + q0 + wq * 32) * PITCH + h * 128 + c * 64;
    const bf16_t* Kh = PROJ + rowbase * PITCH + ATTW + h * 128;
    const bf16_t* Vh = PROJ + rowbase * PITCH + 2 * ATTW + h * 128;
    const unsigned lds0 = (unsigned)(uintptr_t)shm;
    const lds_cptr shm3 = (lds_cptr)shm;
    DA_LAS float* wsf = (DA_LAS float*)(shm3 + LDS_WS) + wid * 64;
    const bf16_t* ksrc = Kh + (long)lane * PITCH + wid * 8;
    const bf16_t* vsrc = Vh + (long)(16 * (wid & 3) + (lane >> 2)) * PITCH + (wid >> 2) * 32 + (lane & 3) * 8;
    const unsigned kdst = lds0 + LDS_K + wid * 1024, vdst = lds0 + LDS_V + wid * 1024;
#define DA_RFL(x) ((unsigned)__builtin_amdgcn_readfirstlane((int)(x)))
#define DA_DMA_TILE(t, slot) do { const long go_ = (long)(t) * KVBLK * PITCH; const unsigned so_ = (unsigned)(slot); \
        glds16(ksrc + go_, DA_RFL(kdst + so_)); glds16(ksrc + go_ + 64, DA_RFL(kdst + so_ + 8192)); \
        glds16(vsrc + go_, DA_RFL(vdst + so_)); glds16(vsrc + go_ + 64, DA_RFL(vdst + so_ + 8192)); } while (0)
    const int NT = 2 * (qb + 1);
    DA_DMA_TILE(0, 0); DA_DMA_TILE(1, SLOTB);
    bf16x8 qr[4];
#pragma unroll
    for (int d0 = 0; d0 < 4; ++d0) qr[d0] = *(const bf16x8*)(Qw + (long)r32 * PITCH + d0 * 16 + hi * 8);
    float m = -1e30f, l = 0.f;
    f32x16 o[4];
#pragma unroll
    for (int i = 0; i < 4; ++i) o[i] = f32x16{};
    int s_cur = 0, s_nxt = SLOTB, s_free = 2 * SLOTB;
    const lds_cptr kp0 = shm3 + LDS_K + c * 8192 + hi * 1024 + r32 * 16;
    const lds_cptr vp0 = shm3 + LDS_V + ((lane >> 4) & 1) * 32 + (lane & 3) * 8 + (4 * hi + ((lane & 15) >> 2)) * 64;
    const int qrel = wq * 32 + r32;
    for (int t = 0; t < NT; ++t) {
        if (t + 1 < NT) { DA_WAIT_BAR(4); } else { DA_WAIT_BAR(0); }
        if (t + 2 < NT) DA_DMA_TILE(t + 2, s_free);
        f32x16 p0 = f32x16{}, p1 = f32x16{};
        { const lds_cptr kp = kp0 + s_cur;
#pragma unroll
          for (int d0 = 0; d0 < 4; ++d0) { const bf16x8 b0 = *(const DA_LAS bf16x8*)(kp + d0 * 2048), b1 = *(const DA_LAS bf16x8*)(kp + d0 * 2048 + 512);
              p0 = DA_MFMA(b0, qr[d0], p0); p1 = DA_MFMA(b1, qr[d0], p1); } }
        if (t >= NT - 2) { const int kb = 64 * (t - (NT - 2)) + 4 * hi;
#pragma unroll
            for (int r = 0; r < 16; ++r) { const int kv = kb + (r & 3) + 8 * (r >> 2); if (kv > qrel) p0[r] = -INFINITY; if (kv + 32 > qrel) p1[r] = -INFINITY; } }
        float rm = fmaxf(p0[0], p1[0]);
#pragma unroll
        for (int r = 1; r < 16; ++r) rm = fmaxf(rm, fmaxf(p0[r], p1[r]));
        { auto rr = __builtin_amdgcn_permlane32_swap(__float_as_uint(rm), __float_as_uint(rm), false, false); rm = fmaxf(__uint_as_float(rr[0]), __uint_as_float(rr[1])); }
        if (__any(rm > m + THR)) {
            const float mn = fmaxf(m, rm), f = __builtin_amdgcn_exp2f(m - mn); m = mn; l *= f;
            if (hi == 0) wsf[r32] = f;
#pragma unroll
            for (int r = 0; r < 16; ++r) { const float fr_ = wsf[crow(r, hi)];
#pragma unroll
                for (int db = 0; db < 4; ++db) o[db][r] *= fr_; }
        }
        float sacc = 0.f;
#pragma unroll
        for (int r = 0; r < 16; ++r) { p0[r] = __builtin_amdgcn_exp2f(p0[r] - m); p1[r] = __builtin_amdgcn_exp2f(p1[r] - m); sacc += p0[r] + p1[r]; }
        l += sacc;
        u32x4 pw[4];
#pragma unroll
        for (int i = 0; i < 4; ++i) { pw[0][i] = cvtpk_s(p0[2 * i], p0[2 * i + 1]); pw[1][i] = cvtpk_s(p0[8 + 2 * i], p0[9 + 2 * i]); pw[2][i] = cvtpk_s(p1[2 * i], p1[2 * i + 1]); pw[3][i] = cvtpk_s(p1[8 + 2 * i], p1[9 + 2 * i]); }
        { const lds_cptr vp = vp0 + s_cur;
#pragma unroll
          for (int db = 0; db < 4; ++db)
#pragma unroll
              for (int ks = 0; ks < 4; ++ks) { const s16x4 lo = vtr(vp + db * 4096 + ks * 1024), hv = vtr(vp + db * 4096 + ks * 1024 + 512);
                  const bf16x8 vf = (bf16x8){lo[0], lo[1], lo[2], lo[3], hv[0], hv[1], hv[2], hv[3]};
                  o[db] = DA_MFMA(__builtin_bit_cast(bf16x8, pw[ks]), vf, o[db]); } }
        { const int tmp = s_cur; s_cur = s_nxt; s_nxt = s_free; s_free = tmp; }
    }
    { auto rr = __builtin_amdgcn_permlane32_swap(__float_as_uint(l), __float_as_uint(l), false, false); l = __uint_as_float(rr[0]) + __uint_as_float(rr[1]); }
    if (hi == 0) wsf[32 + r32] = (c == 1 ? lam : 1.0f) / l;
    asm volatile("s_waitcnt lgkmcnt(0)\n\ts_barrier" ::: "memory");
    DA_LAS float* xch = (DA_LAS float*)(shm3 + LDS_XCH) + wq * 4096;
    if (c == 1) {
#pragma unroll
        for (int r = 0; r < 16; ++r) { const float rl = wsf[32 + crow(r, hi)];
#pragma unroll
            for (int db = 0; db < 4; ++db) xch[(db * 16 + r) * 64 + lane] = o[db][r] * rl; }
    }
    asm volatile("s_waitcnt lgkmcnt(0)\n\ts_barrier" ::: "memory");
    if (c == 0) {
#pragma unroll
        for (int r = 0; r < 16; ++r) { const float rl = wsf[32 + crow(r, hi)];
#pragma unroll
            for (int db = 0; db < 4; ++db) o[db][r] = o[db][r] * rl - xch[(db * 16 + r) * 64 + lane]; }
        asm volatile("s_waitcnt lgkmcnt(0)" ::: "memory");
#pragma unroll
        for (int r = 0; r < 16; ++r)
#pragma unroll
            for (int db = 0; db < 4; ++db) xch[crow(r, hi) * 128 + db * 32 + r32] = o[db][r];
        asm volatile("s_waitcnt lgkmcnt(0)" ::: "memory");
        const int dcol = 8 * (lane & 15);
        const f32x4 g0 = *(const f32x4*)(sg + dcol), g1 = *(const f32x4*)(sg + dcol + 4);
        bf16_t* Ow = MIX + (rowbase + q0 + wq * 32) * DM + h * 128 + dcol;
#pragma unroll
        for (int i = 0; i < 8; ++i) { const int row = 4 * i + (lane >> 4);
            const f32x4 v0 = *(const DA_LAS f32x4*)(xch + row * 128 + dcol), v1 = *(const DA_LAS f32x4*)(xch + row * 128 + dcol + 4);
            float ss = ((v0[0] * v0[0] + v0[1] * v0[1]) + (v0[2] * v0[2] + v0[3] * v0[3])) + ((v1[0] * v1[0] + v1[1] * v1[1]) + (v1[2] * v1[2] + v1[3] * v1[3]));
            ss += __shfl_xor(ss, 1); ss += __shfl_xor(ss, 2); ss += __shfl_xor(ss, 4); ss += __shfl_xor(ss, 8);
            const float rs = oml0 / sqrtf(ss * (1.0f / DV) + EPS);
            const f32x4 y0 = v0 * g0 * rs, y1 = v1 * g1 * rs;
            u32x4 w; w.x = cvtpk_s(y0[0], y0[1]); w.y = cvtpk_s(y0[2], y0[3]); w.z = cvtpk_s(y1[0], y1[1]); w.w = cvtpk_s(y1[2], y1[3]);
            *(u32x4*)(Ow + (long)row * DM) = w; }
    }
    asm volatile("s_waitcnt lgkmcnt(0)\n\ts_barrier" ::: "memory");
#undef DA_DMA_TILE
#undef DA_RFL
}
template <int W> __device__ __forceinline__ void pool_rows4(const bf16_t* PROJ, bf16_t* MIX, int row0, int g, int lane) {
    const int row = row0 + (lane >> 4), c8 = g * 128 + (lane & 15) * 8, t = row & (SEQ - 1);
    const bf16_t* up = PROJ + (size_t)row * INW + 3 * ATTW + c8;
    u32x4 v[W];
#pragma unroll
    for (int i = 0; i < W; ++i) v[i] = *(const u32x4*)(up - (size_t)(i <= t ? i : t) * INW);
    float s[8];
#pragma unroll
    for (int j = 0; j < 8; ++j) s[j] = 0.f;
#pragma unroll
    for (int i = 0; i < W; ++i) { const float msk = (i <= t) ? 1.0f : 0.0f;
#pragma unroll
        for (int j = 0; j < 4; ++j) { s[2 * j] = fmaf(msk, __uint_as_float(v[i][j] << 16), s[2 * j]); s[2 * j + 1] = fmaf(msk, __uint_as_float(v[i][j] & 0xffff0000u), s[2 * j + 1]); } }
    const float rn = 1.0f / (float)((t + 1 < W) ? (t + 1) : W); u32x4 o;
#pragma unroll
    for (int j = 0; j < 4; ++j) o[j] = cvtpk_s(s[2 * j] * rn - __uint_as_float(v[0][j] << 16), s[2 * j + 1] * rn - __uint_as_float(v[0][j] & 0xffff0000u));
    *(u32x4*)(MIX + (size_t)row * DM + ATTW + c8) = o;
}
__device__ __forceinline__ void attn_pool_phase(char* lds, const bf16_t* PROJ, bf16_t* MIX, const float* lam_qk, float lam0, const float* sg, int vcu, int G) {
    const int lane = threadIdx.x & 63;
    float s1 = lam_qk[lane] * lam_qk[64 + lane], s2 = lam_qk[128 + lane] * lam_qk[192 + lane];
#pragma unroll
    for (int o = 1; o < 64; o <<= 1) { s1 += __shfl_xor(s1, o); s2 += __shfl_xor(s2, o); }
    const float lam = expf(s1) - expf(s2) + lam0;
    for (int v = vcu; v < BATCH * NH * 8; v += G) { const int bh = v >> 3, s = v & 7;
        attn_unit(bh >> 2, bh & 3, s, PROJ, MIX, lam, sg, 1.0f - lam0, lds);
        attn_unit(bh >> 2, bh & 3, 15 - s, PROJ, MIX, lam, sg, 1.0f - lam0, lds); }
    { const int wave = __builtin_amdgcn_readfirstlane((int)threadIdx.x >> 6);
      for (int it = vcu * 8 + wave; it < M; it += G * 8) { const int g = it & 3, row0 = (it >> 2) * 4;
          if (g == 0) pool_rows4<2>(PROJ, MIX, row0, 0, lane); else if (g == 1) pool_rows4<4>(PROJ, MIX, row0, 1, lane);
          else if (g == 2) pool_rows4<8>(PROJ, MIX, row0, 2, lane); else pool_rows4<16>(PROJ, MIX, row0, 3, lane); } }
}
#undef DA_WAIT_BAR
#undef DA_MFMA
}

constexpr int NWAVES = 8;
constexpr int NPHASE = 2 + 5 * DEPTH;
constexpr size_t MiB = 1u << 20;
constexpr size_t WS_CTL = 0, CTL_ZERO_BYTES = 65536;
constexpr size_t WS_W1 = 1 * MiB;
constexpr size_t WS_WO = 9 * MiB;
constexpr size_t WS_WGU = 13 * MiB;
constexpr size_t WS_WD = 35 * MiB;
constexpr size_t WS_SSQ = 46 * MiB;
constexpr size_t WS_XB = 48 * MiB;
constexpr size_t WS_PROJ = 80 * MiB;
constexpr size_t WS_MIX = 144 * MiB;
constexpr size_t WS_H = 80 * MiB;
constexpr size_t WS_END = 176 * MiB;
static_assert(WS_H + (size_t)M * DFF * 2 <= WS_END && WS_MIX + (size_t)M * DM * 2 <= WS_END && WS_SSQ + (size_t)M * NSSQ * 4 <= WS_XB, "ws map");
constexpr int CW_BAR = 1024;
constexpr int RING_OFF = 0, RING_BYTES = 131072;
constexpr int LDSCTL_OFF = RING_BYTES, MISC_OFF = LDSCTL_OFF + 320;
constexpr int LDS_BYTES = 147456;
static_assert(MISC_OFF + 128 <= LDS_BYTES && dattn::LDS_BYTES <= RING_BYTES && pg8::STAGE_BYTES <= RING_BYTES, "LDS map");

#define GAS __attribute__((address_space(1)))
#define LAS __attribute__((address_space(3)))
typedef unsigned short bf16;
typedef unsigned v4u __attribute__((ext_vector_type(4)));
typedef unsigned v2u __attribute__((ext_vector_type(2)));
typedef float f32x4 __attribute__((ext_vector_type(4)));
typedef short bf16x8 __attribute__((ext_vector_type(8)));
typedef GAS unsigned gu32;
#define RLX_AGENT __ATOMIC_RELAXED, __HIP_MEMORY_SCOPE_AGENT
#define LDS_WAIT() asm volatile("s_waitcnt lgkmcnt(0)" ::: "memory")
__device__ __forceinline__ unsigned f2bf(float f) { unsigned u = __builtin_bit_cast(unsigned, f); return (u + 0x7fffu + ((u >> 16) & 1u)) >> 16; }
__device__ __forceinline__ unsigned pk2(float lo, float hi) { return f2bf(lo) | (f2bf(hi) << 16); }
__device__ __forceinline__ float bf2f(bf16 b) { return __builtin_bit_cast(float, (unsigned)b << 16); }

#define XB_TMO      128
#define XB_XCNT(j)  (256  + 64 * (j))
#define XB_XSUB(j)  (1280 + 64 * (j))
#define XB_XGEN(j)  (2304 + 64 * (j))
#define XB_TOP      3328
#define XB_TOPGEN   3392
#define XCD_BAR_WORDS 3456
#define XB_SPIN_CAP (1u << 18)

__device__ __forceinline__ unsigned xb_ld(unsigned* p)              { return __hip_atomic_load(p, __ATOMIC_RELAXED, __HIP_MEMORY_SCOPE_AGENT); }
__device__ __forceinline__ unsigned xb_add(unsigned* p, unsigned v) { return __hip_atomic_fetch_add(p, v, __ATOMIC_RELAXED, __HIP_MEMORY_SCOPE_AGENT); }
__device__ __forceinline__ unsigned xb_xcc_id() { return (unsigned)__builtin_amdgcn_s_getreg((3 << 11) | 20) & 0xFu; }
#define XB_SPIN(cond, bar) do { unsigned _sp = 0; while (cond) { __builtin_amdgcn_s_sleep(1); \
    if ((++_sp & 255u) == 0u) { if (xb_ld(&(bar)[XB_TMO])) break; if (_sp > XB_SPIN_CAP) { atomicAdd(&(bar)[XB_TMO], 1u); break; } } } } while (0)

struct XcdBarrier {
    unsigned* bar; unsigned x;
    volatile LAS unsigned* st;
};

__device__ __forceinline__ XcdBarrier xcd_barrier_post(unsigned* bar, volatile LAS unsigned* st) {
    XcdBarrier b; b.bar = bar; b.x = xb_xcc_id(); b.st = st;
    if (threadIdx.x == 0) (void)xb_add(&bar[XB_XCNT(b.x)], 1u);
    return b;
}
__device__ __forceinline__ void xcd_barrier_complete(unsigned* bar, unsigned x, unsigned& nloc, unsigned& nx) {
    const unsigned G = gridDim.x * gridDim.y * gridDim.z;
    unsigned sum, cnt, mine, sp = 0u;
    for (;;) {
        sum = 0u; cnt = 0u; mine = 0u;
#pragma unroll
        for (unsigned j = 0; j < 16; ++j) { const unsigned c = xb_ld(&bar[XB_XCNT(j)]); sum += c; cnt += (c > 0u) ? 1u : 0u; mine = (j == x) ? c : mine; }
        if (sum == G) break;
        __builtin_amdgcn_s_sleep(1);
        if ((++sp & 255u) == 0u) { if (xb_ld(&bar[XB_TMO])) break; if (sp > XB_SPIN_CAP) { atomicAdd(&bar[XB_TMO], 1u); break; } }
    }
    nloc = mine > 0u ? mine : 1u; nx = cnt > 0u ? cnt : 1u;
}

__device__ __forceinline__ void xcd_barrier(const XcdBarrier& b) {
    asm volatile("s_waitcnt vmcnt(0)" ::: "memory");
    __syncthreads();
    if (threadIdx.x == 0) {
        unsigned* bar = b.bar;
        __builtin_amdgcn_s_waitcnt(0);
        unsigned nloc = b.st[0], nx = b.st[1];
        if (nloc == 0u) { xcd_barrier_complete(bar, b.x, nloc, nx); b.st[0] = nloc; b.st[1] = nx; }
        const unsigned old = xb_add(&bar[XB_XSUB(b.x)], 1u);
        const unsigned gen = old / nloc;
        if (old + 1u == (gen + 1u) * nloc) {
            __builtin_amdgcn_fence(__ATOMIC_RELEASE, "agent");
            asm volatile("s_waitcnt vmcnt(0)" ::: "memory");
            const unsigned og = xb_add(&bar[XB_TOP], 1u);
            const unsigned tg = og / nx;
            if (og + 1u == (tg + 1u) * nx) xb_add(&bar[XB_TOPGEN], 1u);
            else XB_SPIN(xb_ld(&bar[XB_TOPGEN]) == tg, bar);
            __builtin_amdgcn_fence(__ATOMIC_ACQUIRE, "agent");
            xb_add(&bar[XB_XGEN(b.x)], 1u);
            asm volatile("s_waitcnt vmcnt(0)" ::: "memory");
        } else {
            XB_SPIN(xb_ld(&bar[XB_XGEN(b.x)]) == gen, bar);
            __builtin_amdgcn_fence(__ATOMIC_ACQUIRE, "agent");
            asm volatile("s_waitcnt vmcnt(0)" ::: "memory");
        }
    }
    __syncthreads();
}

__device__ __forceinline__ float wave_sum(float v) {
#pragma unroll
    for (int o = 1; o < 64; o <<= 1) v += __shfl_xor(v, o);
    return v;
}
__device__ __forceinline__ void transpose_item(const float* W, int N, bf16* WT, int ldk, int k0, int n0, int rbase, LAS float* scr, int lane) {
    f32x4 t[8];
#pragma unroll
    for (int i = 0; i < 8; ++i) t[i] = *(const GAS f32x4*)(W + (size_t)(k0 + 8 * i + (lane >> 3)) * N + n0 + 4 * (lane & 7));
#pragma unroll
    for (int i = 0; i < 8; ++i) { LAS float* d = scr + (8 * i + (lane >> 3)) * 33 + 4 * (lane & 7); d[0] = t[i][0]; d[1] = t[i][1]; d[2] = t[i][2]; d[3] = t[i][3]; }
    LDS_WAIT(); asm volatile("" ::: "memory");
    const int c = lane & 7;
#pragma unroll
    for (int j = 0; j < 4; ++j) { const int n = (lane >> 3) + 8 * j; const LAS float* s = scr + (8 * c) * 33 + n;
        v4u o; o.x = pk2(s[0 * 33], s[1 * 33]); o.y = pk2(s[2 * 33], s[3 * 33]); o.z = pk2(s[4 * 33], s[5 * 33]); o.w = pk2(s[6 * 33], s[7 * 33]);
        *(GAS v4u*)(WT + (size_t)(rbase + n) * ldk + k0 + 8 * c) = o; }
    LDS_WAIT(); asm volatile("" ::: "memory");
}
struct Ptrs {
    const float *x, *norm1_g, *w_in, *lam_qk, *subln_g, *pool_w, *pool_scale, *w_out, *norm2_g, *w_gate, *w_up, *w_down, *final_g;
    float* out; bf16 *W1, *WO, *WGU, *WD, *XB, *PROJ, *MIX, *H; float* SSQ;
};
__device__ __forceinline__ void p0_prologue(const Ptrs& P, LAS unsigned char* lds, int vcu, int G, int wave, int lane) {
    LAS float* scr = (LAS float*)(lds + RING_OFF + wave * 16384);
    const int gw = vcu * NWAVES + wave, NGW = G * NWAVES;
    constexpr int I_IN = (DM / 64) * (INW / 32), I_OUT = (ATTW / 64) * (DM / 32), I_G = (DM / 64) * (DFF / 32), I_D = (DFF / 64) * (DM / 32), I_LAYER = I_IN + I_OUT + 2 * I_G + I_D;
    for (int it = gw; it < DEPTH * I_LAYER; it += NGW) {
        const int l = it / I_LAYER; int r = it % I_LAYER;
        if (r < I_IN) { const int nb = INW / 32; transpose_item(P.w_in + (size_t)l * DM * INW, INW, P.W1 + (size_t)l * INW * DM, DM, 64 * (r / nb), 32 * (r % nb), 32 * (r % nb), scr, lane); continue; } r -= I_IN;
        if (r < I_OUT) { const int nb = DM / 32; transpose_item(P.w_out + (size_t)l * DM * DM, DM, P.WO + (size_t)l * DM * DM, DM, 64 * (r / nb), 32 * (r % nb), 32 * (r % nb), scr, lane); continue; } r -= I_OUT;
        if (r < 2 * I_G) { const int up = r >= I_G; if (up) r -= I_G; const int nb = DFF / 32, n0 = 32 * (r % nb);
            transpose_item((up ? P.w_up : P.w_gate) + (size_t)l * DM * DFF, DFF, P.WGU + (size_t)l * NGU * DM, DM, 64 * (r / nb), n0, 256 * (n0 / 128) + (n0 % 128) + 128 * up, scr, lane); continue; } r -= 2 * I_G;
        { const int nb = DM / 32; transpose_item(P.w_down + (size_t)l * DFF * DM, DM, P.WD + (size_t)l * DM * DFF, DFF, 64 * (r / nb), 32 * (r % nb), 32 * (r % nb), scr, lane); }
    }
    for (int it = gw; it < DEPTH * 4 * 16 * 16; it += NGW) {
        const int l = it >> 10, g = (it >> 8) & 3, c0 = ((it >> 4) & 15) * 8, n = (it & 15) * 64 + lane;
        typedef const __attribute__((address_space(4))) float* cfp;
        cfp pw = (cfp)(P.pool_w + (size_t)l * 4 * 128 * 128 + ((size_t)g * 128 + c0) * 128); cfp sc = (cfp)(P.pool_scale + l * 512 + 128 * g);
        const GAS float* wo = (const GAS float*)(P.w_out + (size_t)l * DM * DM + (size_t)(512 + 128 * g) * DM + n);
        float acc[8];
#pragma unroll
        for (int j = 0; j < 8; ++j) acc[j] = 0.f;
#pragma unroll 16
        for (int d = 0; d < 128; ++d) { const float w = wo[(size_t)d * DM] * sc[d];
#pragma unroll
            for (int j = 0; j < 8; ++j) acc[j] = fmaf(pw[j * 128 + d], w, acc[j]); }
        v4u o; o.x = pk2(acc[0], acc[1]); o.y = pk2(acc[2], acc[3]); o.z = pk2(acc[4], acc[5]); o.w = pk2(acc[6], acc[7]);
        *(GAS v4u*)(P.WO + (size_t)l * DM * DM + (size_t)n * DM + 512 + 128 * g + c0) = o;
    }
    for (int row = gw; row < M; row += NGW) {
        const GAS f32x4* xr = (const GAS f32x4*)(P.x + (size_t)row * DM) + lane; const GAS f32x4* gr = (const GAS f32x4*)P.norm1_g + lane; float s = 0.f;
#pragma unroll
        for (int j = 0; j < 4; ++j) { const f32x4 v = xr[64 * j], gg = gr[64 * j]; s += (v.x * v.x + v.y * v.y) + (v.z * v.z + v.w * v.w);
            v2u o; o.x = pk2(v.x * gg.x, v.y * gg.y); o.y = pk2(v.z * gg.z, v.w * gg.w); *((GAS v2u*)(P.XB + (size_t)row * DM) + lane + 64 * j) = o; }
        s = wave_sum(s);
        if (lane < 4) *((GAS f32x4*)(P.SSQ + (size_t)row * NSSQ) + lane) = (f32x4){lane == 0 ? s : 0.f, 0.f, 0.f, 0.f};
    }
}
__device__ __forceinline__ void final_norm(float* outp, const float* fg, int vcu, int G, int wave, int lane) {
    const int gw = vcu * NWAVES + wave, NGW = G * NWAVES;
    for (int row = gw; row < M; row += NGW) {
        GAS f32x4* xr = (GAS f32x4*)(outp + (size_t)row * DM) + lane; const GAS f32x4* gr = (const GAS f32x4*)fg + lane;
        f32x4 v[4]; float s = 0.f;
#pragma unroll
        for (int j = 0; j < 4; ++j) { v[j] = xr[64 * j]; s += (v[j].x * v[j].x + v[j].y * v[j].y) + (v[j].z * v[j].z + v[j].w * v[j].w); }
        const float r = 1.0f / sqrtf(wave_sum(s) * (1.0f / DM) + EPS);
#pragma unroll
        for (int j = 0; j < 4; ++j) xr[64 * j] = v[j] * r * gr[64 * j];
    }
}

struct Args { const float* in[13]; float* out; unsigned char* ws; int ph_lo, ph_hi; };
typedef const __attribute__((address_space(4))) Args* kargs_t;
#define KARGS(A_) kargs_t A_ = (kargs_t)__builtin_amdgcn_kernarg_segment_ptr(); asm volatile("" : "+s"(A_))
__device__ __forceinline__ void fill_ptrs(Ptrs& P, kargs_t A) {
    unsigned char* ws = A->ws;
    P.x = A->in[0]; P.norm1_g = A->in[1]; P.w_in = A->in[2]; P.lam_qk = A->in[3]; P.subln_g = A->in[4]; P.pool_w = A->in[5]; P.pool_scale = A->in[6]; P.w_out = A->in[7];
    P.norm2_g = A->in[8]; P.w_gate = A->in[9]; P.w_up = A->in[10]; P.w_down = A->in[11]; P.final_g = A->in[12]; P.out = A->out;
    P.W1 = (bf16*)(ws + WS_W1); P.WO = (bf16*)(ws + WS_WO); P.WGU = (bf16*)(ws + WS_WGU); P.WD = (bf16*)(ws + WS_WD); P.XB = (bf16*)(ws + WS_XB);
    P.PROJ = (bf16*)(ws + WS_PROJ); P.MIX = (bf16*)(ws + WS_MIX); P.H = (bf16*)(ws + WS_H); P.SSQ = (float*)(ws + WS_SSQ);
}
__global__ void __launch_bounds__(NWAVES * 64, 2) mk_fwd(Args args) {
    extern __shared__ __attribute__((aligned(16))) unsigned char lds_raw[];
    LAS unsigned char* lds = (LAS unsigned char*)lds_raw;
    volatile LAS unsigned* MISC = (volatile LAS unsigned*)(lds + MISC_OFF);
    const int tid = threadIdx.x, lane = tid & 63, wave = __builtin_amdgcn_readfirstlane(tid >> 6);
    const int G = gridDim.x; const int bx = blockIdx.x; const int vcu = (G % 8 == 0) ? (bx % 8) * (G / 8) + bx / 8 : bx;
    for (int u = tid; u < (LDS_BYTES - LDSCTL_OFF) / 4; u += NWAVES * 64) ((LAS unsigned*)(lds + LDSCTL_OFF))[u] = 0u;
    __syncthreads();
    const int lo = args.ph_lo, hi = args.ph_hi;
    XcdBarrier bar; bar.bar = (unsigned*)(args.ws + WS_CTL) + CW_BAR; bar.x = 0; bar.st = nullptr;
    if (hi - lo > 1) bar = xcd_barrier_post((unsigned*)(args.ws + WS_CTL) + CW_BAR, MISC + 8);
#ifndef MK_EN
#define MK_EN 0xffu
#endif
#define IN(k) (lo <= (k) && (k) < hi)
#define SEAM(k) do { if (IN(k) && IN((k) + 1)) xcd_barrier(bar); } while (0)

    if (IN(0) && (MK_EN & 1u)) { KARGS(A); Ptrs P; fill_ptrs(P, A); p0_prologue(P, lds, vcu, G, wave, lane); SEAM(0); }

    for (int l = 0; l < DEPTH; ++l) {
        const int pb = 1 + 5 * l;
        if (IN(pb) && (MK_EN & 2u)) {
            KARGS(A); unsigned char* ws = A->ws;
            pg8::Gemm g{(const bf16*)(ws + WS_XB), (const bf16*)(ws + WS_W1) + (size_t)l * INW * DM, M, INW, DM}; pg8::StaticOrder S; S.init(M, INW, G, bx);
            pg8::EpiProj E{(bf16*)(ws + WS_PROJ), (const float*)(ws + WS_SSQ)};
            pg8::gemm_phase<pg8::EpiProj, pg8::StaticOrder, true, true>(lds + RING_OFF, g, S, E);
            SEAM(pb);
        }
        if (IN(pb + 1) && (MK_EN & 4u)) {
            KARGS(A); unsigned char* ws = A->ws;
            dattn::attn_pool_phase((char*)lds_raw + RING_OFF, (const bf16*)(ws + WS_PROJ), (bf16*)(ws + WS_MIX), A->in[3] + l * 256, l == 0 ? LAM0_0 : LAM0_1, A->in[4] + l * DV, vcu, G);
            SEAM(pb + 1);
        }
        if (IN(pb + 2) && (MK_EN & 8u)) {
            KARGS(A); unsigned char* ws = A->ws; float* out = A->out;
            pg8::Gemm g{(const bf16*)(ws + WS_MIX), (const bf16*)(ws + WS_WO) + (size_t)l * DM * DM, M, DM, DM}; pg8::StaticOrder S; S.init(M, DM, G, bx);
            pg8::EpiRes E{l == 0 ? A->in[0] : out, out, (bf16*)(ws + WS_XB), A->in[8] + l * DM, (float*)(ws + WS_SSQ)};
            pg8::gemm_phase<pg8::EpiRes, pg8::StaticOrder, true, true>(lds + RING_OFF, g, S, E);
            SEAM(pb + 2);
        }
        if (IN(pb + 3) && (MK_EN & 16u)) {
            KARGS(A); unsigned char* ws = A->ws;
            pg8::Gemm g{(const bf16*)(ws + WS_XB), (const bf16*)(ws + WS_WGU) + (size_t)l * NGU * DM, M, NGU, DM}; pg8::StaticOrder S; S.init(M, NGU, G, bx);
            pg8::EpiSwiglu E{(bf16*)(ws + WS_H), (const float*)(ws + WS_SSQ)};
            pg8::gemm_phase<pg8::EpiSwiglu, pg8::StaticOrder, true, true>(lds + RING_OFF, g, S, E);
            SEAM(pb + 3);
        }
        if (IN(pb + 4) && (MK_EN & 32u)) {
            KARGS(A); unsigned char* ws = A->ws; float* out = A->out;
            pg8::Gemm g{(const bf16*)(ws + WS_H), (const bf16*)(ws + WS_WD) + (size_t)l * DM * DFF, M, DM, DFF}; pg8::StaticOrder S; S.init(M, DM, G, bx);
            pg8::EpiRes E{out, out, (l + 1 < DEPTH) ? (bf16*)(ws + WS_XB) : nullptr, A->in[1] + (l + 1 < DEPTH ? (l + 1) * DM : 0), (float*)(ws + WS_SSQ)};
            pg8::gemm_phase<pg8::EpiRes, pg8::StaticOrder, true, true>(lds + RING_OFF, g, S, E);
            SEAM(pb + 4);
        }
    }
    if (IN(NPHASE - 1) && (MK_EN & 64u)) { KARGS(A); final_norm(A->out, A->in[12], vcu, G, wave, lane); }
#undef IN
#undef SEAM
}

#ifndef MK_ONE_LAUNCH
#define MK_ONE_LAUNCH 1
#endif
#ifndef MK_NAIVE_MASK
#define MK_NAIVE_MASK 0u
#endif
#if !MK_ONE_LAUNCH
constexpr size_t WS_LAM = 47 * MiB;
__global__ void __launch_bounds__(256) k_transpose(const float* __restrict__ W, int K, int N, bf16* __restrict__ WT, int ldk, int row_off, int mode) {
    __shared__ float scr_all[4][64 * 33];
    const int wave = threadIdx.x >> 6, lane = threadIdx.x & 63;
    float* scr = scr_all[wave];
    const int nblk = N / 32, nitems = (K / 64) * nblk;
    for (int item = blockIdx.x * 4 + wave; item < nitems; item += gridDim.x * 4) {
        const int kb = item / nblk, nb = item % nblk, k0 = 64 * kb, n0 = 32 * nb;
        for (int i = 0; i < 32; ++i) { const int kk = 2 * i + (lane >> 5); scr[kk * 33 + (lane & 31)] = W[(size_t)(k0 + kk) * N + n0 + (lane & 31)]; }
        __builtin_amdgcn_wave_barrier(); asm volatile("s_waitcnt lgkmcnt(0)" ::: "memory");
        const int c = lane & 7;
        const int rbase = (mode == 1) ? (256 * (n0 / 128) + (n0 % 128) + row_off) : (row_off + n0);
        for (int j = 0; j < 4; ++j) { const int n = (lane >> 3) + 8 * j; const float* s = scr + (8 * c) * 33 + n;
            uint4 o; o.x = pk2(s[0 * 33], s[1 * 33]); o.y = pk2(s[2 * 33], s[3 * 33]); o.z = pk2(s[4 * 33], s[5 * 33]); o.w = pk2(s[6 * 33], s[7 * 33]);
            *(uint4*)(WT + (size_t)(rbase + n) * ldk + k0 + 8 * c) = o; }
        asm volatile("s_waitcnt lgkmcnt(0)" ::: "memory"); __builtin_amdgcn_wave_barrier();
    }
}
__global__ void __launch_bounds__(256) k_fold_pool(const float* __restrict__ pool_w, const float* __restrict__ scale, const float* __restrict__ w_out, bf16* __restrict__ WoT) {
    const int idx = blockIdx.x * 256 + threadIdx.x;
    const int n = idx & 1023, gc = idx >> 10, g = gc >> 7, c = gc & 127;
    const float* pw = pool_w + ((size_t)g * 128 + c) * 128; const float* sc = scale + 128 * g; const float* wo = w_out + (size_t)(512 + 128 * g) * DM + n;
    float acc = 0.f;
    for (int d = 0; d < 128; ++d) acc = fmaf(pw[d] * sc[d], wo[(size_t)d * DM], acc);
    WoT[(size_t)n * DM + 512 + gc] = (bf16)f2bf(acc);
}
__global__ void k_lambda(const float* __restrict__ lam_qk, float* __restrict__ lam_out) {
    const int l = threadIdx.x; if (l >= DEPTH) return;
    const float* q = lam_qk + l * 256; float s1 = 0.f, s2 = 0.f;
    for (int i = 0; i < 64; ++i) { s1 += q[i] * q[64 + i]; s2 += q[128 + i] * q[192 + i]; }
    lam_out[l] = expf(s1) - expf(s2) + (l == 0 ? LAM0_0 : LAM0_1);
}
__global__ void __launch_bounds__(256) k_prep_x(const float* __restrict__ x, const float* __restrict__ g, bf16* __restrict__ XB, float* __restrict__ SSQ) {
    const int row = blockIdx.x * 4 + (threadIdx.x >> 6), lane = threadIdx.x & 63;
    const f32x4* xr = (const f32x4*)(x + (size_t)row * DM) + lane; const f32x4* gr = (const f32x4*)g + lane;
    float s = 0.f;
    for (int j = 0; j < 4; ++j) { const f32x4 v = xr[64 * j], gg = gr[64 * j]; s += (v.x * v.x + v.y * v.y) + (v.z * v.z + v.w * v.w);
        uint2 o; o.x = pk2(v.x * gg.x, v.y * gg.y); o.y = pk2(v.z * gg.z, v.w * gg.w); *((uint2*)(XB + (size_t)row * DM) + lane + 64 * j) = o; }
    for (int o = 1; o < 64; o <<= 1) s += __shfl_xor(s, o);
    if (lane < 4) *((f32x4*)(SSQ + (size_t)row * NSSQ) + lane) = (f32x4){lane == 0 ? s : 0.f, 0.f, 0.f, 0.f};
}
enum { EPI_PROJ = 0, EPI_RES = 1, EPI_SWIGLU = 2 };
struct EpiArgs { bf16* outb; float* outf; const float* base; const float* SSQ; int ldc; int pad; };
template <int EPI, int NB> __global__ void __launch_bounds__(256) k_gemm(const bf16* __restrict__ A, const bf16* __restrict__ Bt, int K, EpiArgs e) {
    const int lane = threadIdx.x & 63, w = threadIdx.x >> 6, fr = lane & 15, fq = lane >> 4;
    const int m0 = blockIdx.y * 128 + 64 * (w >> 1), n0 = blockIdx.x * (NB * 128) + 64 * (w & 1);
    f32x4 acc[NB][4][4];
    for (int g = 0; g < NB; ++g) for (int i = 0; i < 4; ++i) for (int j = 0; j < 4; ++j) acc[g][i][j] = (f32x4){0.f, 0.f, 0.f, 0.f};
    const bf16* ap = A + (size_t)(m0 + fr) * K + 8 * fq; const bf16* bp = Bt + (size_t)(n0 + fr) * K + 8 * fq;
    for (int k0 = 0; k0 < K; k0 += 32) {
        bf16x8 af[4], bfr[NB][4];
#pragma unroll
        for (int i = 0; i < 4; ++i) af[i] = *(const bf16x8*)(ap + (size_t)(16 * i) * K + k0);
#pragma unroll
        for (int g = 0; g < NB; ++g)
#pragma unroll
            for (int j = 0; j < 4; ++j) bfr[g][j] = *(const bf16x8*)(bp + (size_t)(128 * g + 16 * j) * K + k0);
#pragma unroll
        for (int g = 0; g < NB; ++g)
#pragma unroll
            for (int i = 0; i < 4; ++i)
#pragma unroll
                for (int j = 0; j < 4; ++j) acc[g][i][j] = __builtin_amdgcn_mfma_f32_16x16x32_bf16(bfr[g][j], af[i], acc[g][i][j], 0, 0, 0);
    }
#pragma unroll
    for (int i = 0; i < 4; ++i) {
        const int row = m0 + 16 * i + fr;
        if (EPI == EPI_PROJ) {
            const float r = pg8::rstd16(e.SSQ, row);
#pragma unroll
            for (int j = 0; j < 4; ++j) { const int col = n0 + 16 * j + 4 * fq; const float s = (col < ATTW) ? r * C2 : r; const f32x4 v = acc[0][i][j] * s;
                uint2 o; o.x = pk2(v.x, v.y); o.y = pk2(v.z, v.w); *(uint2*)(e.outb + (size_t)row * e.ldc + col) = o; }
        } else if (EPI == EPI_RES) {
#pragma unroll
            for (int j = 0; j < 4; ++j) { const int col = n0 + 16 * j + 4 * fq; const f32x4 b = *(const f32x4*)(e.base + (size_t)row * e.ldc + col);
                *(f32x4*)(e.outf + (size_t)row * e.ldc + col) = b + acc[0][i][j]; }
        } else {
            const float r = pg8::rstd16(e.SSQ, row);
#pragma unroll
            for (int j = 0; j < 4; ++j) { const int col = blockIdx.x * 128 + 64 * (w & 1) + 16 * j + 4 * fq;
                const f32x4 gt = acc[0][i][j] * r, up = acc[NB - 1][i][j] * r; f32x4 h;
                for (int q = 0; q < 4; ++q) h[q] = gt[q] / (1.0f + __expf(-gt[q])) * up[q];
                uint2 o; o.x = pk2(h.x, h.y); o.y = pk2(h.z, h.w); *(uint2*)(e.outb + (size_t)row * e.ldc + col) = o; }
        }
    }
}
__global__ void __launch_bounds__(128) k_attn_naive(const bf16* __restrict__ PROJ, bf16* __restrict__ MIX, const float* __restrict__ lamp, int layer, const float* __restrict__ subln_g, float one_minus_lam0) {
    __shared__ float s1[SEQ], s2[SEQ], qv[128], red[8];
    const int tid = threadIdx.x, qpos = blockIdx.x, h = blockIdx.y, b = blockIdx.z;
    const size_t row = (size_t)b * SEQ + qpos;
    qv[tid] = bf2f(PROJ[row * INW + h * 128 + tid]);
    __syncthreads();
    float m1 = -INFINITY, m2 = -INFINITY;
    for (int j = tid; j <= qpos; j += 128) {
        const bf16* kr = PROJ + ((size_t)b * SEQ + j) * INW + ATTW + h * 128; float a1 = 0.f, a2 = 0.f;
        for (int d = 0; d < 64; ++d) { a1 += qv[d] * bf2f(kr[d]); a2 += qv[64 + d] * bf2f(kr[64 + d]); }
        s1[j] = a1; s2[j] = a2; m1 = fmaxf(m1, a1); m2 = fmaxf(m2, a2);
    }
    for (int o = 1; o < 64; o <<= 1) { m1 = fmaxf(m1, __shfl_xor(m1, o)); m2 = fmaxf(m2, __shfl_xor(m2, o)); }
    if ((tid & 63) == 0) { red[tid >> 6] = m1; red[2 + (tid >> 6)] = m2; }
    __syncthreads();
    m1 = fmaxf(red[0], red[1]); m2 = fmaxf(red[2], red[3]);
    float l1 = 0.f, l2 = 0.f;
    for (int j = tid; j <= qpos; j += 128) { const float p1 = exp2f(s1[j] - m1), p2 = exp2f(s2[j] - m2); s1[j] = p1; s2[j] = p2; l1 += p1; l2 += p2; }
    for (int o = 1; o < 64; o <<= 1) { l1 += __shfl_xor(l1, o); l2 += __shfl_xor(l2, o); }
    if ((tid & 63) == 0) { red[4 + (tid >> 6)] = l1; red[6 + (tid >> 6)] = l2; }
    __syncthreads();
    l1 = red[4] + red[5]; l2 = red[6] + red[7];
    float o1 = 0.f, o2 = 0.f;
    const bf16* vp = PROJ + (size_t)b * SEQ * INW + 2 * ATTW + h * 128 + tid;
    for (int j = 0; j <= qpos; ++j) { const float v = bf2f(vp[(size_t)j * INW]); o1 = fmaf(s1[j], v, o1); o2 = fmaf(s2[j], v, o2); }
    const float lam = lamp[layer];
    const float a = o1 / l1 - lam * (o2 / l2);
    float ss = a * a;
    for (int o = 1; o < 64; o <<= 1) ss += __shfl_xor(ss, o);
    __syncthreads();
    if ((tid & 63) == 0) red[tid >> 6] = ss;
    __syncthreads();
    ss = red[0] + red[1];
    const float y = a * (1.0f / sqrtf(ss * (1.0f / DV) + EPS)) * subln_g[tid] * one_minus_lam0;
    MIX[row * DM + h * 128 + tid] = (bf16)f2bf(y);
}
__global__ void __launch_bounds__(256) k_pool_naive(const bf16* __restrict__ PROJ, bf16* __restrict__ MIX) {
    const int idx = blockIdx.x * 256 + threadIdx.x, c = idx & 511, row = idx >> 9, t = row & (SEQ - 1), g = c >> 7, w = 2 << g;
    const int n = (t + 1 < w) ? (t + 1) : w;
    const bf16* up = PROJ + (size_t)row * INW + 3 * ATTW + c; float s = 0.f;
    for (int i = 0; i < n; ++i) s += bf2f(*(up - (size_t)i * INW));
    MIX[(size_t)row * DM + ATTW + c] = (bf16)f2bf(s / (float)n - bf2f(*up));
}
__global__ void __launch_bounds__(256) k_final(float* __restrict__ x, const float* __restrict__ g) {
    const int row = blockIdx.x * 4 + (threadIdx.x >> 6), lane = threadIdx.x & 63;
    f32x4* xr = (f32x4*)(x + (size_t)row * DM) + lane; const f32x4* gr = (const f32x4*)g + lane;
    f32x4 v[4]; float s = 0.f;
    for (int j = 0; j < 4; ++j) { v[j] = xr[64 * j]; s += (v[j].x * v[j].x + v[j].y * v[j].y) + (v[j].z * v[j].z + v[j].w * v[j].w); }
    for (int o = 1; o < 64; o <<= 1) s += __shfl_xor(s, o);
    const float r = 1.0f / sqrtf(s * (1.0f / DM) + EPS);
    for (int j = 0; j < 4; ++j) xr[64 * j] = v[j] * r * gr[64 * j];
}
static void naive_phase(int p, const Ptrs& P, unsigned char* ws, hipStream_t stream) {
    float* LAM = (float*)(ws + WS_LAM);
    if (p == 0) {
        for (int l = 0; l < DEPTH; ++l) {
            k_transpose<<<512, 256, 0, stream>>>(P.w_in + (size_t)l * DM * INW, DM, INW, P.W1 + (size_t)l * INW * DM, DM, 0, 0);
            k_transpose<<<512, 256, 0, stream>>>(P.w_out + (size_t)l * DM * DM, ATTW, DM, P.WO + (size_t)l * DM * DM, DM, 0, 0);
            k_transpose<<<512, 256, 0, stream>>>(P.w_gate + (size_t)l * DM * DFF, DM, DFF, P.WGU + (size_t)l * NGU * DM, DM, 0, 1);
            k_transpose<<<512, 256, 0, stream>>>(P.w_up + (size_t)l * DM * DFF, DM, DFF, P.WGU + (size_t)l * NGU * DM, DM, 128, 1);
            k_transpose<<<512, 256, 0, stream>>>(P.w_down + (size_t)l * DFF * DM, DFF, DM, P.WD + (size_t)l * DM * DFF, DFF, 0, 0);
            k_fold_pool<<<512 * 1024 / 256, 256, 0, stream>>>(P.pool_w + (size_t)l * 4 * 128 * 128, P.pool_scale + l * 512, P.w_out + (size_t)l * DM * DM, P.WO + (size_t)l * DM * DM);
        }
        k_prep_x<<<M / 4, 256, 0, stream>>>(P.x, P.norm1_g, P.XB, P.SSQ);
        return;
    }
    if (p == NPHASE - 1) { k_final<<<M / 4, 256, 0, stream>>>(P.out, P.final_g); return; }
    const int l = (p - 1) / 5, k = (p - 1) % 5;
    if (k == 0) { EpiArgs e{P.PROJ, nullptr, nullptr, P.SSQ, INW, 0}; k_gemm<EPI_PROJ, 1><<<dim3(INW / 128, M / 128), 256, 0, stream>>>(P.XB, P.W1 + (size_t)l * INW * DM, DM, e); }
    if (k == 1) { k_lambda<<<1, 64, 0, stream>>>(P.lam_qk, LAM);
        k_attn_naive<<<dim3(SEQ, NH, BATCH), 128, 0, stream>>>(P.PROJ, P.MIX, LAM, l, P.subln_g + l * DV, 1.0f - (l == 0 ? LAM0_0 : LAM0_1));
        k_pool_naive<<<M * 512 / 256, 256, 0, stream>>>(P.PROJ, P.MIX); }
    if (k == 2) { EpiArgs e{nullptr, P.out, l == 0 ? P.x : P.out, nullptr, DM, 0}; k_gemm<EPI_RES, 1><<<dim3(DM / 128, M / 128), 256, 0, stream>>>(P.MIX, P.WO + (size_t)l * DM * DM, DM, e);
        k_prep_x<<<M / 4, 256, 0, stream>>>(P.out, P.norm2_g + l * DM, P.XB, P.SSQ); }
    if (k == 3) { EpiArgs e{P.H, nullptr, nullptr, P.SSQ, DFF, 0}; k_gemm<EPI_SWIGLU, 2><<<dim3(DFF / 128, M / 128), 256, 0, stream>>>(P.XB, P.WGU + (size_t)l * NGU * DM, DM, e); }
    if (k == 4) { EpiArgs e{nullptr, P.out, P.out, nullptr, DM, 0}; k_gemm<EPI_RES, 1><<<dim3(DM / 128, M / 128), 256, 0, stream>>>(P.H, P.WD + (size_t)l * DM * DFF, DFF, e);
        if (l + 1 < DEPTH) k_prep_x<<<M / 4, 256, 0, stream>>>(P.out, P.norm1_g + (l + 1) * DM, P.XB, P.SSQ); }
}
#endif

extern "C" void kernel_launch(void* const* d_in, const int* in_sizes, int n_in, void* d_out, int out_size, void* d_ws, size_t ws_size, hipStream_t stream) {
    static int grid = 0;
    if (grid == 0) {
        if (n_in != 13 || in_sizes[0] != M * DM || out_size != M * DM || ws_size < WS_END) { fprintf(stderr, "kernel_launch: unexpected shapes (n_in %d, ws %zu); nothing launched\n", n_in, ws_size); grid = -1; return; }
        int dev = 0, cus = 0, per_cu = 0;
        if (hipGetDevice(&dev) != hipSuccess || hipDeviceGetAttribute(&cus, hipDeviceAttributeMultiprocessorCount, dev) != hipSuccess) { fprintf(stderr, "kernel_launch: device query failed\n"); grid = -1; return; }
        if (hipFuncSetAttribute((const void*)mk_fwd, hipFuncAttributeMaxDynamicSharedMemorySize, LDS_BYTES) != hipSuccess) { fprintf(stderr, "kernel_launch: hipFuncSetAttribute failed\n"); grid = -1; return; }
        if (hipOccupancyMaxActiveBlocksPerMultiprocessor(&per_cu, (const void*)mk_fwd, NWAVES * 64, LDS_BYTES) != hipSuccess || per_cu < 1)
            fprintf(stderr, "kernel_launch: note: occupancy query reports %d workgroups per CU\n", per_cu);
        (void)hipGetLastError();
        grid = cus;
    }
    if (grid < 0) return;
    if (hipMemsetAsync((char*)d_ws + WS_CTL, 0, CTL_ZERO_BYTES, stream) != hipSuccess) { fprintf(stderr, "kernel_launch: hipMemsetAsync failed\n"); return; }
    Args a{};
    for (int i = 0; i < 13; ++i) a.in[i] = (const float*)d_in[i];
    a.out = (float*)d_out; a.ws = (unsigned char*)d_ws;
#if MK_ONE_LAUNCH
    a.ph_lo = 0; a.ph_hi = NPHASE;
    hipLaunchKernelGGL(mk_fwd, dim3(grid), dim3(NWAVES * 64), LDS_BYTES, stream, a);
#else
    unsigned char* ws = (unsigned char*)d_ws;
    Ptrs P;
    P.x = a.in[0]; P.norm1_g = a.in[1]; P.w_in = a.in[2]; P.lam_qk = a.in[3]; P.subln_g = a.in[4]; P.pool_w = a.in[5]; P.pool_scale = a.in[6]; P.w_out = a.in[7];
    P.norm2_g = a.in[8]; P.w_gate = a.in[9]; P.w_up = a.in[10]; P.w_down = a.in[11]; P.final_g = a.in[12]; P.out = a.out;
    P.W1 = (bf16*)(ws + WS_W1); P.WO = (bf16*)(ws + WS_WO); P.WGU = (bf16*)(ws + WS_WGU); P.WD = (bf16*)(ws + WS_WD); P.XB = (bf16*)(ws + WS_XB);
    P.PROJ = (bf16*)(ws + WS_PROJ); P.MIX = (bf16*)(ws + WS_MIX); P.H = (bf16*)(ws + WS_H); P.SSQ = (float*)(ws + WS_SSQ);
    for (int p = 0; p < NPHASE; ++p) {
        if ((MK_NAIVE_MASK >> p) & 1u) { naive_phase(p, P, ws, stream); continue; }
        a.ph_lo = p; a.ph_hi = p + 1;
        hipLaunchKernelGGL(mk_fwd, dim3(grid), dim3(NWAVES * 64), LDS_BYTES, stream, a);
#ifdef MK_DUP_MASK
        if ((MK_DUP_MASK >> p) & 1u) hipLaunchKernelGGL(mk_fwd, dim3(grid), dim3(NWAVES * 64), LDS_BYTES, stream, a);
#endif
    }
#endif
    const hipError_t le = hipPeekAtLastError();
    if (le != hipSuccess) fprintf(stderr, "kernel_launch: launch failed: %s (grid %d)\n", hipGetErrorName(le), grid);
}
```

```cpp
#include <hip/hip_runtime.h>
#include <cstdio>
#include <cstdint>
#include <cmath>

constexpr int BATCH = 8, SEQ = 2048, DM = 1024, DEPTH = 2, M = BATCH * SEQ;
constexpr int NH = 4, DV = 128, ATTW = 512, INW = 2048, DFF = 2816, NGU = 2 * DFF;
constexpr float EPS = 1e-5f;
constexpr float C2 = 0.125f * 1.4426950408889634f;
constexpr float LAM0_0 = 0.2f, LAM0_1 = 0.35550906759096926f;
constexpr int NSSQ = 16;

#define MK_ONE_LAUNCH 1
#define MK_NAIVE_MASK 0u
namespace pg8 {
#define PG8_LAS __attribute__((address_space(3)))
typedef unsigned short bf16_t;
typedef short bf16x8 __attribute__((ext_vector_type(8)));
typedef float f32x4 __attribute__((ext_vector_type(4)));
typedef unsigned u32x4 __attribute__((ext_vector_type(4)));
constexpr int BM = 256, BK = 64, HALF = 128, HTB = HALF * BK * 2  , STAGE_BYTES = 8 * HTB, NXCD = 8, WGM = 8;

__host__ __device__ __forceinline__ int lds_byte(int r, int c) { const int st = (r >> 4) * 2 + (c >> 5), rr = r & 15, cc = c & 31, ob = rr * 64 + cc * 2; return st * 1024 + (ob ^ (((ob >> 9) & 1) << 5)); }
__host__ __device__ __forceinline__ void stage_rc(int b, int& R, int& C) { const int st = b / 1024, sb = b % 1024, swz = sb ^ (((sb >> 9) & 1) << 5); R = (st >> 1) * 16 + swz / 64; C = (st & 1) * 32 + (swz % 64) / 2; }
__host__ __device__ __forceinline__ int perm32(int rho) { const int n = rho >> 4, i = rho & 15; return 8 * (i >> 2) + 4 * n + (i & 3); }

struct Unit { int pm, pn; };
struct Gemm { const bf16_t* A; const bf16_t* Bt; int M, N, K; };

struct StaticOrder {
    int nM, nN, nwg, G, c;
    __host__ __device__ void init(int M, int N, int G_, int c_) { nM = M / BM; nN = N / BM; nwg = nM * nN; G = G_; c = c_; }
    __host__ __device__ bool next(int i, Unit& u) const {
        const long L = (long)i * G + c; if (L >= nwg) return false;
        int wgid = (int)L; { const int q = nwg / NXCD, r = nwg % NXCD, xcd = wgid % NXCD, off = wgid / NXCD; wgid = (xcd < r ? xcd * (q + 1) : r * (q + 1) + (xcd - r) * q) + off; }
        const int nig = WGM * nN, gid = wgid / nig, fm = gid * WGM, gsz = (nM - fm) < WGM ? (nM - fm) : WGM;
        u.pm = fm + ((wgid % nig) % gsz); u.pn = (wgid % nig) / gsz; return true;
    }
    __device__ __forceinline__ void a_ready(const Unit&) const {}
    __device__ __forceinline__ void done(const Unit&) const {}
};

__device__ __forceinline__ unsigned cvt_pk_bf16(float lo, float hi) { unsigned r; asm volatile("v_cvt_pk_bf16_f32 %0, %1, %2" : "=v"(r) : "v"(lo), "v"(hi)); return r; }
__device__ __forceinline__ float rstd16(const float* SSQ, int row) {
    const f32x4* p = (const f32x4*)(SSQ + (size_t)row * NSSQ); const f32x4 a = p[0], b = p[1], c = p[2], d = p[3];
    const float s = ((a[0] + a[1]) + (a[2] + a[3])) + ((b[0] + b[1]) + (b[2] + b[3])) + ((c[0] + c[1]) + (c[2] + c[3])) + ((d[0] + d[1]) + (d[2] + d[3]));
    return 1.0f / sqrtf(s * (1.0f / DM) + EPS);
}
struct EpiProj {
    static constexpr bool PERM = true, AFTER_DRAIN = false;
    bf16_t* O; const float* SSQ;
    __device__ __forceinline__ void operator()(const f32x4 (&acc)[2][2][4][2], const Unit& u, int wr, int wc, int fr, int fq) const {
        const int row0 = u.pm * BM + wr * 64 + fr, col0 = u.pn * BM + wc * 32 + 8 * fq;
        const float qs = (u.pn < 2) ? C2 : 1.0f;
#pragma unroll
        for (int ai = 0; ai < 2; ++ai)
#pragma unroll
            for (int m = 0; m < 4; ++m) { const int row = row0 + ai * HALF + m * 16; const float r = rstd16(SSQ, row) * qs; bf16_t* rowp = O + (size_t)row * INW + col0;
#pragma unroll
                for (int bj = 0; bj < 2; ++bj) { const f32x4 v0 = acc[ai][bj][m][0] * r, v1 = acc[ai][bj][m][1] * r;
                    u32x4 w; w.x = cvt_pk_bf16(v0[0], v0[1]); w.y = cvt_pk_bf16(v0[2], v0[3]); w.z = cvt_pk_bf16(v1[0], v1[1]); w.w = cvt_pk_bf16(v1[2], v1[3]);
                    *(u32x4*)(rowp + bj * HALF) = w; } }
    }
};
struct EpiSwiglu {
    static constexpr bool PERM = true, AFTER_DRAIN = false;
    bf16_t* O; const float* SSQ;
    __device__ __forceinline__ void operator()(const f32x4 (&acc)[2][2][4][2], const Unit& u, int wr, int wc, int fr, int fq) const {
        const int row0 = u.pm * BM + wr * 64 + fr, col0 = u.pn * HALF + wc * 32 + 8 * fq;
#pragma unroll
        for (int ai = 0; ai < 2; ++ai)
#pragma unroll
            for (int m = 0; m < 4; ++m) { const int row = row0 + ai * HALF + m * 16; const float r = rstd16(SSQ, row); float hv[8];
#pragma unroll
                for (int n = 0; n < 2; ++n)
#pragma unroll
                    for (int q = 0; q < 4; ++q) { const float g = acc[ai][0][m][n][q] * r, up = acc[ai][1][m][n][q] * r;
                        hv[4 * n + q] = g * __builtin_amdgcn_rcpf(1.0f + __builtin_amdgcn_exp2f(-1.4426950408889634f * g)) * up; }
                u32x4 w; w.x = cvt_pk_bf16(hv[0], hv[1]); w.y = cvt_pk_bf16(hv[2], hv[3]); w.z = cvt_pk_bf16(hv[4], hv[5]); w.w = cvt_pk_bf16(hv[6], hv[7]);
                *(u32x4*)(O + (size_t)row * DFF + col0) = w; }
    }
};
struct EpiRes {
    static constexpr bool PERM = true, AFTER_DRAIN = false;
    const float* base; float* out; bf16_t* XB; const float* gain; float* SSQ;
    __device__ __forceinline__ void operator()(const f32x4 (&acc)[2][2][4][2], const Unit& u, int wr, int wc, int fr, int fq) const {
        const int row0 = u.pm * BM + wr * 64 + fr, col0 = u.pn * BM + wc * 32 + 8 * fq;
        f32x4 gv[2][2];
#pragma unroll
        for (int bj = 0; bj < 2; ++bj)
#pragma unroll
            for (int n = 0; n < 2; ++n) gv[bj][n] = XB ? *(const f32x4*)(gain + col0 + bj * HALF + 4 * n) : (f32x4){0.f, 0.f, 0.f, 0.f};
#pragma unroll
        for (int ai = 0; ai < 2; ++ai)
#pragma unroll
            for (int m = 0; m < 4; ++m) { const int row = row0 + ai * HALF + m * 16; const size_t off = (size_t)row * DM + col0; float ss = 0.f;
#pragma unroll
                for (int bj = 0; bj < 2; ++bj) { f32x4 x0 = *(const f32x4*)(base + off + bj * HALF), x1 = *(const f32x4*)(base + off + bj * HALF + 4);
                    x0 += acc[ai][bj][m][0]; x1 += acc[ai][bj][m][1];
                    *(f32x4*)(out + off + bj * HALF) = x0; *(f32x4*)(out + off + bj * HALF + 4) = x1;
                    ss += ((x0[0] * x0[0] + x0[1] * x0[1]) + (x0[2] * x0[2] + x0[3] * x0[3])) + ((x1[0] * x1[0] + x1[1] * x1[1]) + (x1[2] * x1[2] + x1[3] * x1[3]));
                    if (XB) { const f32x4 y0 = x0 * gv[bj][0], y1 = x1 * gv[bj][1];
                        u32x4 w; w.x = cvt_pk_bf16(y0[0], y0[1]); w.y = cvt_pk_bf16(y0[2], y0[3]); w.z = cvt_pk_bf16(y1[0], y1[1]); w.w = cvt_pk_bf16(y1[2], y1[3]);
                        *(u32x4*)(XB + off + bj * HALF) = w; } }
                ss += __shfl_xor(ss, 16); ss += __shfl_xor(ss, 32);
                if (fq == 0) SSQ[(size_t)row * NSSQ + 4 * u.pn + wc] = ss;
                asm volatile("" ::: "memory"); }
    }
};

template <class Epi, class Sched, bool ALIGN_EPI = false, bool SP2 = false>
__device__ __forceinline__ void gemm_phase(PG8_LAS unsigned char* lds, const Gemm g, const Sched& S, const Epi& E) {
    int tid_o = threadIdx.x; asm volatile("" : "+v"(tid_o));
    const int tid = tid_o, wid = __builtin_amdgcn_readfirstlane(tid >> 6), lane = tid & 63, wr = wid >> 2, wc = wid & 3, fr = lane & 15, fq = lane >> 4;
    const int K = g.K, nt = K / BK;
    unsigned voffA[2], voffB[2];
#pragma unroll
    for (int i = 0; i < 2; ++i) { int R, C; stage_rc(tid * 16 + i * 8192, R, C); const int Rb = Epi::PERM ? ((R & ~31) + perm32(R & 31)) : R;
        voffA[i] = (unsigned)(R * K + C) * 2u; voffB[i] = (unsigned)(Rb * K + C) * 2u; }
    const size_t kstep = (size_t)(BK * 2);
    const size_t hstep = (size_t)HALF * K * 2;
    const size_t tstep = 2 * hstep;
    const unsigned ldsw = (unsigned)wid * 1024u;
    const int aoff = lds_byte(wr * 64 + fr, fq * 8), boff = lds_byte(wc * 32 + fr, fq * 8);
#define PG8_SA(b, h) (((b) * 2 + (h)) * HTB)
#define PG8_SB(b, h) ((4 + (b) * 2 + (h)) * HTB)
#define PG8_STAGE(bufoff, gbase, voff) do { _Pragma("unroll") for (int _i = 0; _i < 2; ++_i) \
        __builtin_amdgcn_global_load_lds((const unsigned*)((const char*)(gbase) + (voff)[_i]), (PG8_LAS unsigned*)(lds + (bufoff) + ldsw + _i * 8192), 16, 0, 0); } while (0)
#define PG8_LDA(dst, b, h) do { _Pragma("unroll") for (int m = 0; m < 4; ++m) _Pragma("unroll") for (int k = 0; k < 2; ++k) dst[m][k] = *(const PG8_LAS bf16x8*)(lds + PG8_SA(b, h) + aoff + m * 2048 + k * 1024); } while (0)
#define PG8_LDB(dst, b, h) do { _Pragma("unroll") for (int n = 0; n < 2; ++n) _Pragma("unroll") for (int k = 0; k < 2; ++k) dst[n][k] = *(const PG8_LAS bf16x8*)(lds + PG8_SB(b, h) + boff + n * 2048 + k * 1024); } while (0)
#define PG8_MMA(ai, bj, At, Bt) do { __builtin_amdgcn_s_setprio(1); _Pragma("unroll") for (int m = 0; m < 4; ++m) _Pragma("unroll") for (int n = 0; n < 2; ++n) _Pragma("unroll") for (int k = 0; k < 2; ++k) \
        acc[ai][bj][m][n] = __builtin_amdgcn_mfma_f32_16x16x32_bf16(Bt[n][k], At[m][k], acc[ai][bj][m][n], 0, 0, 0); __builtin_amdgcn_s_setprio(0); } while (0)
#define PG8_WAIT_V(n) asm volatile("s_waitcnt vmcnt(" #n ")" ::: "memory")
#define PG8_WAIT_L(n) asm volatile("s_waitcnt lgkmcnt(" #n ")" ::: "memory")
#define PG8_BAR __builtin_amdgcn_s_barrier()
#define PG8_SCHED __builtin_amdgcn_sched_barrier(0)
    Unit cur, nxt; int ui = 0;
    if (!S.next(0, cur)) return;
    f32x4 acc[2][2][4][2];
#pragma unroll
    for (int a = 0; a < 2; ++a)
#pragma unroll
        for (int b = 0; b < 2; ++b)
#pragma unroll
            for (int m = 0; m < 4; ++m)
#pragma unroll
                for (int n = 0; n < 2; ++n) acc[a][b][m][n] = (f32x4){0.f, 0.f, 0.f, 0.f};
    bf16x8 At[4][2], B0[2][2], B1[2][2];
    const char* cA = (const char*)g.A + (size_t)cur.pm * tstep; const char* cB = (const char*)g.Bt + (size_t)cur.pn * tstep;
    S.a_ready(cur);
    if constexpr (SP2) {
        PG8_STAGE(PG8_SB(0, 0), cB, voffB); PG8_STAGE(PG8_SB(0, 1), cB + hstep, voffB); PG8_STAGE(PG8_SA(0, 0), cA, voffA); PG8_STAGE(PG8_SA(0, 1), cA + hstep, voffA);
        if (wr == 1) PG8_BAR;
        PG8_WAIT_V(2); PG8_BAR;
        PG8_STAGE(PG8_SB(1, 0), cB + kstep, voffB); PG8_STAGE(PG8_SA(1, 0), cA + kstep, voffA); PG8_STAGE(PG8_SB(1, 1), cB + hstep + kstep, voffB);
        PG8_WAIT_V(6); PG8_BAR;
    } else {
        PG8_STAGE(PG8_SB(0, 0), cB, voffB); PG8_STAGE(PG8_SA(0, 0), cA, voffA); PG8_STAGE(PG8_SB(0, 1), cB + hstep, voffB); PG8_STAGE(PG8_SA(0, 1), cA + hstep, voffA);
        if (wr == 1) PG8_BAR;
        PG8_WAIT_V(4); PG8_BAR;
        PG8_STAGE(PG8_SB(1, 0), cB + kstep, voffB); PG8_STAGE(PG8_SA(1, 0), cA + kstep, voffA); PG8_STAGE(PG8_SB(1, 1), cB + hstep + kstep, voffB);
        PG8_WAIT_V(6); PG8_BAR;
    }
    for (;;) {
        const bool has_next = S.next(ui + 1, nxt);
        const char* nA = has_next ? (const char*)g.A + (size_t)nxt.pm * tstep : cA; const char* nB = has_next ? (const char*)g.Bt + (size_t)nxt.pn * tstep : cB;
        for (int t = 0; t < nt; t += 2) {
            const bool last = (t == nt - 2);
            const char* a1 = cA + (size_t)(t + 1) * kstep;
            const char* a2 = last ? nA : cA + (size_t)(t + 2) * kstep; const char* b2 = last ? nB : cB + (size_t)(t + 2) * kstep;
            const char* a3 = a2 + kstep; const char* b3 = b2 + kstep;
            if (last && has_next) S.a_ready(nxt);
            if constexpr (SP2) {
            PG8_LDB(B0, 0, 0); PG8_LDB(B1, 0, 1); PG8_SCHED; PG8_LDA(At, 0, 0); PG8_STAGE(PG8_SA(1, 1), a1 + hstep, voffA);
            PG8_WAIT_V(8); PG8_WAIT_L(0); PG8_BAR; PG8_MMA(0, 0, At, B0); PG8_MMA(0, 1, At, B1); PG8_BAR; PG8_SCHED;
            PG8_LDA(At, 0, 1); PG8_STAGE(PG8_SB(0, 0), b2, voffB); PG8_STAGE(PG8_SB(0, 1), b2 + hstep, voffB); PG8_STAGE(PG8_SA(0, 0), a2, voffA);
            PG8_WAIT_V(8); PG8_WAIT_L(0); PG8_BAR; PG8_MMA(1, 0, At, B0); PG8_MMA(1, 1, At, B1); PG8_BAR; PG8_SCHED;
            PG8_LDB(B0, 1, 0); PG8_LDB(B1, 1, 1); PG8_SCHED; PG8_LDA(At, 1, 0); PG8_STAGE(PG8_SA(0, 1), a2 + hstep, voffA);
            PG8_WAIT_V(8); PG8_WAIT_L(0); PG8_BAR; PG8_MMA(0, 0, At, B0); PG8_MMA(0, 1, At, B1); PG8_BAR; PG8_SCHED;
            PG8_LDA(At, 1, 1); PG8_STAGE(PG8_SB(1, 0), b3, voffB); PG8_STAGE(PG8_SB(1, 1), b3 + hstep, voffB); PG8_STAGE(PG8_SA(1, 0), a3, voffA);
            PG8_WAIT_V(8); PG8_WAIT_L(0); PG8_BAR; PG8_MMA(1, 0, At, B0); PG8_MMA(1, 1, At, B1); PG8_BAR; PG8_SCHED;
            } else {
            PG8_LDB(B0, 0, 0); PG8_SCHED; PG8_LDA(At, 0, 0); PG8_STAGE(PG8_SA(1, 1), a1 + hstep, voffA);
            PG8_WAIT_L(8); PG8_BAR; PG8_WAIT_L(0); PG8_MMA(0, 0, At, B0); PG8_BAR; PG8_SCHED;
            PG8_LDB(B1, 0, 1); PG8_STAGE(PG8_SB(0, 0), b2, voffB);
            PG8_BAR; PG8_WAIT_L(0); PG8_MMA(0, 1, At, B1); PG8_BAR;
            PG8_LDA(At, 0, 1); PG8_STAGE(PG8_SA(0, 0), a2, voffA);
            PG8_BAR; PG8_WAIT_L(0); PG8_MMA(1, 0, At, B0); PG8_BAR; PG8_SCHED;
            PG8_STAGE(PG8_SB(0, 1), b2 + hstep, voffB);
            PG8_WAIT_V(6); PG8_BAR; PG8_MMA(1, 1, At, B1); PG8_BAR;
            PG8_LDB(B0, 1, 0); PG8_SCHED; PG8_LDA(At, 1, 0); PG8_STAGE(PG8_SA(0, 1), a2 + hstep, voffA);
            PG8_WAIT_L(8); PG8_BAR; PG8_WAIT_L(0); PG8_MMA(0, 0, At, B0); PG8_BAR; PG8_SCHED;
            PG8_LDB(B1, 1, 1); PG8_STAGE(PG8_SB(1, 0), b3, voffB);
            PG8_BAR; PG8_WAIT_L(0); PG8_MMA(0, 1, At, B1); PG8_BAR;
            PG8_LDA(At, 1, 1); PG8_STAGE(PG8_SA(1, 0), a3, voffA);
            PG8_BAR; PG8_WAIT_L(0); PG8_MMA(1, 0, At, B0); PG8_BAR; PG8_SCHED;
            PG8_STAGE(PG8_SB(1, 1), b3 + hstep, voffB);
            PG8_WAIT_V(6); PG8_BAR; PG8_MMA(1, 1, At, B1); PG8_BAR;
            }
        }
        if constexpr (ALIGN_EPI) { if (wr == 0) PG8_BAR; }
        if constexpr (!Epi::AFTER_DRAIN) { E(acc, cur, wr, wc, fr, fq); S.done(cur); }
        if (!has_next) break;
#pragma unroll
        for (int a = 0; a < 2; ++a)
#pragma unroll
            for (int b = 0; b < 2; ++b)
#pragma unroll
                for (int m = 0; m < 4; ++m)
#pragma unroll
                    for (int n = 0; n < 2; ++n) acc[a][b][m][n] = (f32x4){0.f, 0.f, 0.f, 0.f};
        cur = nxt; cA = nA; cB = nB; ++ui;
        if constexpr (ALIGN_EPI) { if (wr == 1) PG8_BAR; }
    }
    PG8_WAIT_V(0);
    if constexpr (!ALIGN_EPI) { if (wr == 0) PG8_BAR; }
    PG8_BAR;
    if constexpr (Epi::AFTER_DRAIN) { E.fused(acc, cur, wr, wc, fr, fq, lds, wid, lane); S.done(cur); }
#undef PG8_SA
#undef PG8_SB
#undef PG8_STAGE
#undef PG8_LDA
#undef PG8_LDB
#undef PG8_MMA
#undef PG8_WAIT_V
#undef PG8_WAIT_L
#undef PG8_BAR
#undef PG8_SCHED
}
}
namespace dattn {
typedef unsigned short bf16_t;
typedef short bf16x8 __attribute__((ext_vector_type(8)));
typedef short s16x4 __attribute__((ext_vector_type(4)));
typedef float f32x16 __attribute__((ext_vector_type(16)));
typedef float f32x4 __attribute__((ext_vector_type(4)));
typedef unsigned u32x4 __attribute__((ext_vector_type(4)));
typedef short v4i16_t __attribute__((ext_vector_type(4)));
#define DA_LAS __attribute__((address_space(3)))
typedef DA_LAS const char* lds_cptr;
constexpr int QB = 128, KVBLK = 64, PITCH = INW, NSLOT_K = 3, NSLOT_V = 4, SLOTB = 16384;
constexpr int LDS_K = 0, LDS_V = NSLOT_K * SLOTB, LDS_WS = (NSLOT_K + NSLOT_V) * SLOTB, LDS_BYTES = LDS_WS + 8 * 256;
constexpr int LDS_XCH = 0;
constexpr float THR = 6.0f;
__device__ __forceinline__ int crow(int r, int hi) { return (r & 3) + 8 * (r >> 2) + 4 * hi; }
__device__ __forceinline__ void dma16(unsigned voff, __amdgpu_buffer_rsrc_t srd, unsigned soff, unsigned lds_dst) { unsigned keep;
    asm volatile("s_mov_b32 %0, m0\n\ts_mov_b32 m0, %4\n\ts_nop 4\n\tbuffer_load_dwordx4 %1, %2, %3 offen lds\n\ts_mov_b32 m0, %0" : "=&s"(keep) : "v"(voff), "s"(srd), "s"(soff), "s"(lds_dst) : "memory"); }
typedef float f32x2_t __attribute__((ext_vector_type(2))); typedef __bf16 bf16x2_t __attribute__((ext_vector_type(2)));
__device__ __forceinline__ unsigned cvtpk_s(float lo, float hi) { f32x2_t v = {lo, hi}; bf16x2_t b = __builtin_convertvector(v, bf16x2_t); return __builtin_bit_cast(unsigned, b); }
__device__ __forceinline__ s16x4 vtr(lds_cptr p) { return __builtin_bit_cast(s16x4, __builtin_amdgcn_ds_read_tr16_b64_v4i16((DA_LAS v4i16_t*)p)); }
__device__ __forceinline__ float max3f(float a, float b, float c) { float r; asm("v_max3_f32 %0, %1, %2, %3" : "=v"(r) : "v"(a), "v"(b), "v"(c)); return r; }
__device__ __forceinline__ float max2f(float a, float b) { float r; asm("v_max_f32_e32 %0, %1, %2" : "=v"(r) : "v"(a), "v"(b)); return r; }
#define DA_WAIT_BAR(N) asm volatile("s_waitcnt vmcnt(" #N ") lgkmcnt(0)\n\ts_barrier" ::: "memory")
#define DA_MFMA(a, b, c) __builtin_amdgcn_mfma_f32_32x32x16_bf16(a, b, c, 0, 0, 0)

__device__ __forceinline__ void qk_tile(f32x16& p0, f32x16& p1, lds_cptr kp, const bf16x8 (&qr)[4], const f32x16& negm) {
#pragma unroll
    for (int d0 = 0; d0 < 4; ++d0) { const bf16x8 b0 = *(const DA_LAS bf16x8*)(kp + d0 * 2048), b1 = *(const DA_LAS bf16x8*)(kp + d0 * 2048 + 512);
        if (d0 == 0) { p0 = DA_MFMA(b0, qr[0], negm); p1 = DA_MFMA(b1, qr[0], negm); } else { p0 = DA_MFMA(b0, qr[d0], p0); p1 = DA_MFMA(b1, qr[d0], p1); } }
}
__device__ __forceinline__ void pv_tile(f32x16 (&o)[4], lds_cptr vp, const u32x4 (&pw)[4]) {
#pragma unroll
    for (int db = 0; db < 4; ++db)
#pragma unroll
        for (int ks = 0; ks < 4; ++ks) { const s16x4 lo = vtr(vp + db * 4096 + ks * 1024), hv = vtr(vp + db * 4096 + ks * 1024 + 512);
            const bf16x8 vf = (bf16x8){lo[0], lo[1], lo[2], lo[3], hv[0], hv[1], hv[2], hv[3]};
            o[db] = DA_MFMA(__builtin_bit_cast(bf16x8, pw[ks]), vf, o[db]);
            if (ks == 3) __builtin_amdgcn_sched_barrier(0); }
}
template <bool MASK> __device__ __forceinline__ void softmax_tile(f32x16& p0, f32x16& p1, u32x4 (&pw)[4], f32x16 (&o)[4], f32x16& negm, float& m, float& l, bool first, int kb, int qrel, int hi, int r32, DA_LAS float* wsf) {
    if (MASK) {
#pragma unroll
        for (int r = 0; r < 16; ++r) { const int kv = kb + (r & 3) + 8 * (r >> 2); if (kv > qrel) p0[r] = -INFINITY; if (kv + 32 > qrel) p1[r] = -INFINITY; } }
    float a = max3f(p0[0], p0[1], p1[0]), b = max3f(p0[2], p0[3], p1[1]); a = max3f(a, p1[2], p1[3]);
#pragma unroll
    for (int r = 4; r < 16; r += 4) { a = max3f(a, p0[r], p0[r + 1]); b = max3f(b, p0[r + 2], p0[r + 3]); a = max3f(a, p1[r], p1[r + 1]); b = max3f(b, p1[r + 2], p1[r + 3]); }
    float rm = max2f(a, b);
    { auto rr = __builtin_amdgcn_permlane32_swap(__float_as_uint(rm), __float_as_uint(rm), false, false); rm = max2f(__uint_as_float(rr[0]), __uint_as_float(rr[1])); }
    if (first || __any(rm > THR)) {
        const float dl = first ? rm : fmaxf(rm, 0.f); m += dl;
#pragma unroll
        for (int r = 0; r < 16; ++r) { p0[r] -= dl; p1[r] -= dl; }
#pragma unroll
        for (int r = 0; r < 16; ++r) negm[r] = -m;
        if (!first) { const float f = __builtin_amdgcn_exp2f(-dl); l *= f;
            if (hi == 0) wsf[r32] = f;
#pragma unroll
            for (int r = 0; r < 16; ++r) { const float fr_ = wsf[crow(r, hi)];
#pragma unroll
                for (int db = 0; db < 4; ++db) o[db][r] *= fr_; } }
    }
    float sacc = 0.f;
#pragma unroll
    for (int r = 0; r < 16; ++r) { p0[r] = __builtin_amdgcn_exp2f(p0[r]); p1[r] = __builtin_amdgcn_exp2f(p1[r]); sacc += p0[r] + p1[r]; }
    l += sacc;
#pragma unroll
    for (int i = 0; i < 4; ++i) { pw[0][i] = cvtpk_s(p0[2 * i], p0[2 * i + 1]); pw[1][i] = cvtpk_s(p0[8 + 2 * i], p0[9 + 2 * i]); pw[2][i] = cvtpk_s(p1[2 * i], p1[2 * i + 1]); pw[3][i] = cvtpk_s(p1[8 + 2 * i], p1[9 + 2 * i]); }
}

__device__ __forceinline__ void attn_unit(int b, int h, int qb, const bf16_t* PROJ, bf16_t* MIX, float lam, const float* sg, float oml0, char* shm) {
    int tid_o = threadIdx.x; asm volatile("" : "+v"(tid_o));
    const int tid = tid_o, lane = tid & 63, r32 = lane & 31, hi = lane >> 5;
    const int wid = __builtin_amdgcn_readfirstlane(tid >> 6), c = wid >> 2, wq = wid & 3;
    const long rowbase = (long)b * SEQ; const int q0 = qb * QB;
    const bf16_t* Qw = PROJ + (rowbase + q0 + wq * 32) * PITCH + h * 128 + c * 64;
    const unsigned lds0 = (unsigned)(uintptr_t)shm;
    const lds_cptr shm3 = (lds_cptr)shm;
    DA_LAS float* wsf = (DA_LAS float*)(shm3 + LDS_WS) + wid * 64;
    const __amdgpu_buffer_rsrc_t srd = __builtin_amdgcn_make_buffer_rsrc((void*)(PROJ + rowbase * PITCH), (short)0, SEQ * PITCH * 2, 0x00020000);
    const unsigned kvoff = (unsigned)(lane * PITCH + ATTW + h * 128 + wid * 8) * 2u;
    const unsigned vvoff = (unsigned)((16 * (wid & 3) + (lane >> 2)) * PITCH + 2 * ATTW + h * 128 + (wid >> 2) * 32 + (lane & 3) * 8) * 2u;
    const unsigned kdst = lds0 + LDS_K + wid * 1024, vdst = lds0 + LDS_V + wid * 1024;
#define DA_RFL(x) ((unsigned)__builtin_amdgcn_readfirstlane((int)(x)))
#define DA_DMA_TILE(t, kslot, vslot) do { const unsigned so_ = DA_RFL((unsigned)(t) * (unsigned)(KVBLK * PITCH * 2)); \
        dma16(kvoff, srd, so_, DA_RFL(kdst + (kslot))); dma16(kvoff, srd, so_ + 128u, DA_RFL(kdst + (kslot) + 8192)); \
        dma16(vvoff, srd, so_, DA_RFL(vdst + (vslot))); dma16(vvoff, srd, so_ + 128u, DA_RFL(vdst + (vslot) + 8192)); } while (0)
    const int NT = 2 * (qb + 1);
    DA_DMA_TILE(0, 0, 0); DA_DMA_TILE(1, SLOTB, SLOTB);
    bf16x8 qr[4];
#pragma unroll
    for (int d0 = 0; d0 < 4; ++d0) qr[d0] = *(const bf16x8*)(Qw + (long)r32 * PITCH + d0 * 16 + hi * 8);
    float m = 0.f, l = 0.f;
    f32x16 o[4], negm = f32x16{};
#pragma unroll
    for (int i = 0; i < 4; ++i) o[i] = f32x16{};
    int ks_cur = 0, ks_nxt = SLOTB, ks_free = 2 * SLOTB;
    int vs_prev = 3 * SLOTB, vs_cur = 0, vs_nxt = SLOTB, vs_free = 2 * SLOTB;
    const lds_cptr kp0 = shm3 + LDS_K + c * 8192 + hi * 1024 + r32 * 16;
    const lds_cptr vp0 = shm3 + LDS_V + ((lane >> 4) & 1) * 32 + (lane & 3) * 8 + (4 * hi + ((lane & 15) >> 2)) * 64;
    const int qrel = wq * 32 + r32;
    u32x4 pw[4];
#define DA_STEP(ROLE, MASKED, t) do { \
        if ((t) + 1 < NT) { DA_WAIT_BAR(4); } else { DA_WAIT_BAR(0); }     \
        if ((t) + 2 < NT) DA_DMA_TILE((t) + 2, ks_free, vs_free); \
        f32x16 p0, p1; \
        if (ROLE == 0) { \
            qk_tile(p0, p1, kp0 + ks_cur, qr, negm); \
            softmax_tile<MASKED>(p0, p1, pw, o, negm, m, l, (t) == 0, 64 * ((t) - (NT - 2)) + 4 * hi, qrel, hi, r32, wsf); \
            pv_tile(o, vp0 + vs_cur, pw); \
        } else { \
            if ((t) > 0) pv_tile(o, vp0 + vs_prev, pw); \
            qk_tile(p0, p1, kp0 + ks_cur, qr, negm); \
            softmax_tile<MASKED>(p0, p1, pw, o, negm, m, l, (t) == 0, 64 * ((t) - (NT - 2)) + 4 * hi, qrel, hi, r32, wsf); \
        } \
        { const int tk = ks_cur; ks_cur = ks_nxt; ks_nxt = ks_free; ks_free = tk; const int tv = vs_prev; vs_prev = vs_cur; vs_cur = vs_nxt; vs_nxt = vs_free; vs_free = tv; } \
    } while (0)
    if (c == 0) {
        int t = 0;
        for (; t < NT - 2; ++t) DA_STEP(0, false, t);
        DA_STEP(0, true, t); ++t;
        DA_STEP(0, true, t);
    } else {
        int t = 0;
        for (; t < NT - 2; ++t) DA_STEP(1, false, t);
        DA_STEP(1, true, t); ++t;
        DA_STEP(1, true, t);
        pv_tile(o, vp0 + vs_prev, pw);
    }
#undef DA_STEP
    { auto rr = __builtin_amdgcn_permlane32_swap(__float_as_uint(l), __float_as_uint(l), false, false); l = __uint_as_float(rr[0]) + __uint_as_float(rr[1]); }
    if (hi == 0) wsf[32 + r32] = (c == 1 ? lam : 1.0f) / l;
    asm volatile("s_waitcnt lgkmcnt(0)\n\ts_barrier" ::: "memory");
    DA_LAS float* xch = (DA_LAS float*)(shm3 + LDS_XCH) + wq * 4096;
    if (c == 1) {
#pragma unroll
        for (int r = 0; r < 16; ++r) { const float rl = wsf[32 + crow(r, hi)];
#pragma unroll
            for (int db = 0; db < 4; ++db) xch[(db * 16 + r) * 64 + lane] = o[db][r] * rl; }
    }
    asm volatile("s_waitcnt lgkmcnt(0)\n\ts_barrier" ::: "memory");
    if (c == 0) {
#pragma unroll
        for (int r = 0; r < 16; ++r) { const float rl = wsf[32 + crow(r, hi)];
#pragma unroll
            for (int db = 0; db < 4; ++db) o[db][r] = o[db][r] * rl - xch[(db * 16 + r) * 64 + lane]; }
        asm volatile("s_waitcnt lgkmcnt(0)" ::: "memory");
#pragma unroll
        for (int r = 0; r < 16; ++r)
#pragma unroll
            for (int db = 0; db < 4; ++db) xch[crow(r, hi) * 128 + db * 32 + r32] = o[db][r];
        asm volatile("s_waitcnt lgkmcnt(0)" ::: "memory");
        const int dcol = 8 * (lane & 15);
        const f32x4 g0 = *(const f32x4*)(sg + dcol), g1 = *(const f32x4*)(sg + dcol + 4);
        bf16_t* Ow = MIX + (rowbase + q0 + wq * 32) * DM + h * 128 + dcol;
#pragma unroll
        for (int i = 0; i < 8; ++i) { const int row = 4 * i + (lane >> 4);
            const f32x4 v0 = *(const DA_LAS f32x4*)(xch + row * 128 + dcol), v1 = *(const DA_LAS f32x4*)(xch + row * 128 + dcol + 4);
            float ss = ((v0[0] * v0[0] + v0[1] * v0[1]) + (v0[2] * v0[2] + v0[3] * v0[3])) + ((v1[0] * v1[0] + v1[1] * v1[1]) + (v1[2] * v1[2] + v1[3] * v1[3]));
            ss += __shfl_xor(ss, 1); ss += __shfl_xor(ss, 2); ss += __shfl_xor(ss, 4); ss += __shfl_xor(ss, 8);
            const float rs = oml0 / sqrtf(ss * (1.0f / DV) + EPS);
            const f32x4 y0 = v0 * g0 * rs, y1 = v1 * g1 * rs;
            u32x4 w; w.x = cvtpk_s(y0[0], y0[1]); w.y = cvtpk_s(y0[2], y0[3]); w.z = cvtpk_s(y1[0], y1[1]); w.w = cvtpk_s(y1[2], y1[3]);
            *(u32x4*)(Ow + (long)row * DM) = w; }
    }
    asm volatile("s_waitcnt lgkmcnt(0)\n\ts_barrier" ::: "memory");
#undef DA_DMA_TILE
#undef DA_RFL
}
template <int W> __device__ __forceinline__ void pool_rows4(const bf16_t* PROJ, bf16_t* MIX, int row0, int g, int lane) {
    const int row = row0 + (lane >> 4), c8 = g * 128 + (lane & 15) * 8, t = row & (SEQ - 1);
    const bf16_t* up = PROJ + (size_t)row * INW + 3 * ATTW + c8;
    u32x4 v[W];
#pragma unroll
    for (int i = 0; i < W; ++i) v[i] = *(const u32x4*)(up - (size_t)(i <= t ? i : t) * INW);
    float s[8];
#pragma unroll
    for (int j = 0; j < 8; ++j) s[j] = 0.f;
#pragma unroll
    for (int i = 0; i < W; ++i) { const float msk = (i <= t) ? 1.0f : 0.0f;
#pragma unroll
        for (int j = 0; j < 4; ++j) { s[2 * j] = fmaf(msk, __uint_as_float(v[i][j] << 16), s[2 * j]); s[2 * j + 1] = fmaf(msk, __uint_as_float(v[i][j] & 0xffff0000u), s[2 * j + 1]); } }
    const float rn = 1.0f / (float)((t + 1 < W) ? (t + 1) : W); u32x4 o;
#pragma unroll
    for (int j = 0; j < 4; ++j) o[j] = cvtpk_s(s[2 * j] * rn - __uint_as_float(v[0][j] << 16), s[2 * j + 1] * rn - __uint_as_float(v[0][j] & 0xffff0000u));
    *(u32x4*)(MIX + (size_t)row * DM + ATTW + c8) = o;
}
__device__ __forceinline__ void attn_pool_phase(char* lds, const bf16_t* PROJ, bf16_t* MIX, const float* lam_qk, float lam0, const float* sg, int vcu, int G) {
    const int lane = threadIdx.x & 63;
    float s1 = lam_qk[lane] * lam_qk[64 + lane], s2 = lam_qk[128 + lane] * lam_qk[192 + lane];
#pragma unroll
    for (int o = 1; o < 64; o <<= 1) { s1 += __shfl_xor(s1, o); s2 += __shfl_xor(s2, o); }
    const float lam = expf(s1) - expf(s2) + lam0;
    for (int v = vcu; v < BATCH * NH * 8; v += G) { const int bh = v >> 3, s = v & 7;
        attn_unit(bh >> 2, bh & 3, s, PROJ, MIX, lam, sg, 1.0f - lam0, lds);
        attn_unit(bh >> 2, bh & 3, 15 - s, PROJ, MIX, lam, sg, 1.0f - lam0, lds); }
    { const int wave = __builtin_amdgcn_readfirstlane((int)threadIdx.x >> 6);
      for (int it = vcu * 8 + wave; it < M; it += G * 8) { const int g = it & 3, row0 = (it >> 2) * 4;
          if (g == 0) pool_rows4<2>(PROJ, MIX, row0, 0, lane); else if (g == 1) pool_rows4<4>(PROJ, MIX, row0, 1, lane);
          else if (g == 2) pool_rows4<8>(PROJ, MIX, row0, 2, lane); else pool_rows4<16>(PROJ, MIX, row0, 3, lane); } }
}
#undef DA_WAIT_BAR
#undef DA_MFMA
}

constexpr int NWAVES = 8;
constexpr int NPHASE = 2 + 5 * DEPTH;
constexpr size_t MiB = 1u << 20;
constexpr size_t WS_CTL = 0, CTL_ZERO_BYTES = 65536;
constexpr size_t WS_W1 = 1 * MiB;
constexpr size_t WS_WO = 9 * MiB;
constexpr size_t WS_WGU = 13 * MiB;
constexpr size_t WS_WD = 35 * MiB;
constexpr size_t WS_SSQ = 46 * MiB;
constexpr size_t WS_XB = 48 * MiB;
constexpr size_t WS_PROJ = 80 * MiB;
constexpr size_t WS_MIX = 144 * MiB;
constexpr size_t WS_H = 80 * MiB;
constexpr size_t WS_END = 176 * MiB;
static_assert(WS_H + (size_t)M * DFF * 2 <= WS_END && WS_MIX + (size_t)M * DM * 2 <= WS_END && WS_SSQ + (size_t)M * NSSQ * 4 <= WS_XB, "ws map");
constexpr int CW_BAR = 1024;
constexpr int RING_OFF = 0, RING_BYTES = 131072;
constexpr int LDSCTL_OFF = RING_BYTES, MISC_OFF = LDSCTL_OFF + 320;
constexpr int LDS_BYTES = 147456;
static_assert(MISC_OFF + 128 <= LDS_BYTES && dattn::LDS_BYTES <= RING_BYTES && pg8::STAGE_BYTES <= RING_BYTES, "LDS map");

#define GAS __attribute__((address_space(1)))
#define LAS __attribute__((address_space(3)))
typedef unsigned short bf16;
typedef unsigned v4u __attribute__((ext_vector_type(4)));
typedef unsigned v2u __attribute__((ext_vector_type(2)));
typedef float f32x4 __attribute__((ext_vector_type(4)));
typedef short bf16x8 __attribute__((ext_vector_type(8)));
typedef GAS unsigned gu32;
#define RLX_AGENT __ATOMIC_RELAXED, __HIP_MEMORY_SCOPE_AGENT
#define LDS_WAIT() asm volatile("s_waitcnt lgkmcnt(0)" ::: "memory")
__device__ __forceinline__ unsigned f2bf(float f) { unsigned u = __builtin_bit_cast(unsigned, f); return (u + 0x7fffu + ((u >> 16) & 1u)) >> 16; }
__device__ __forceinline__ unsigned pk2(float lo, float hi) { return f2bf(lo) | (f2bf(hi) << 16); }
__device__ __forceinline__ float bf2f(bf16 b) { return __builtin_bit_cast(float, (unsigned)b << 16); }

#define XB_TMO      128
#define XB_XCNT(j)  (256  + 64 * (j))
#define XB_XSUB(j)  (1280 + 64 * (j))
#define XB_XGEN(j)  (2304 + 64 * (j))
#define XB_TOP      3328
#define XB_TOPGEN   3392
#define XCD_BAR_WORDS 3456
#define XB_SPIN_CAP (1u << 18)

__device__ __forceinline__ unsigned xb_ld(unsigned* p)              { return __hip_atomic_load(p, __ATOMIC_RELAXED, __HIP_MEMORY_SCOPE_AGENT); }
__device__ __forceinline__ unsigned xb_add(unsigned* p, unsigned v) { return __hip_atomic_fetch_add(p, v, __ATOMIC_RELAXED, __HIP_MEMORY_SCOPE_AGENT); }
__device__ __forceinline__ unsigned xb_xcc_id() { return (unsigned)__builtin_amdgcn_s_getreg((3 << 11) | 20) & 0xFu; }
#define XB_SPIN(cond, bar) do { unsigned _sp = 0; while (cond) { __builtin_amdgcn_s_sleep(1); \
    if ((++_sp & 255u) == 0u) { if (xb_ld(&(bar)[XB_TMO])) break; if (_sp > XB_SPIN_CAP) { atomicAdd(&(bar)[XB_TMO], 1u); break; } } } } while (0)

struct XcdBarrier {
    unsigned* bar; unsigned x;
    volatile LAS unsigned* st;
};

__device__ __forceinline__ XcdBarrier xcd_barrier_post(unsigned* bar, volatile LAS unsigned* st) {
    XcdBarrier b; b.bar = bar; b.x = xb_xcc_id(); b.st = st;
    if (threadIdx.x == 0) (void)xb_add(&bar[XB_XCNT(b.x)], 1u);
    return b;
}
__device__ __forceinline__ void xcd_barrier_complete(unsigned* bar, unsigned x, unsigned& nloc, unsigned& nx) {
    const unsigned G = gridDim.x * gridDim.y * gridDim.z;
    unsigned sum, cnt, mine, sp = 0u;
    for (;;) {
        sum = 0u; cnt = 0u; mine = 0u;
#pragma unroll
        for (unsigned j = 0; j < 16; ++j) { const unsigned c = xb_ld(&bar[XB_XCNT(j)]); sum += c; cnt += (c > 0u) ? 1u : 0u; mine = (j == x) ? c : mine; }
        if (sum == G) break;
        __builtin_amdgcn_s_sleep(1);
        if ((++sp & 255u) == 0u) { if (xb_ld(&bar[XB_TMO])) break; if (sp > XB_SPIN_CAP) { atomicAdd(&bar[XB_TMO], 1u); break; } }
    }
    nloc = mine > 0u ? mine : 1u; nx = cnt > 0u ? cnt : 1u;
}

__device__ __forceinline__ void xcd_barrier(const XcdBarrier& b) {
    asm volatile("s_waitcnt vmcnt(0)" ::: "memory");
    __syncthreads();
    if (threadIdx.x == 0) {
        unsigned* bar = b.bar;
        __builtin_amdgcn_s_waitcnt(0);
        unsigned nloc = b.st[0], nx = b.st[1];
        if (nloc == 0u) { xcd_barrier_complete(bar, b.x, nloc, nx); b.st[0] = nloc; b.st[1] = nx; }
        const unsigned old = xb_add(&bar[XB_XSUB(b.x)], 1u);
        const unsigned gen = old / nloc;
        if (old + 1u == (gen + 1u) * nloc) {
            __builtin_amdgcn_fence(__ATOMIC_RELEASE, "agent");
            asm volatile("s_waitcnt vmcnt(0)" ::: "memory");
            const unsigned og = xb_add(&bar[XB_TOP], 1u);
            const unsigned tg = og / nx;
            if (og + 1u == (tg + 1u) * nx) xb_add(&bar[XB_TOPGEN], 1u);
            else XB_SPIN(xb_ld(&bar[XB_TOPGEN]) == tg, bar);
            __builtin_amdgcn_fence(__ATOMIC_ACQUIRE, "agent");
            xb_add(&bar[XB_XGEN(b.x)], 1u);
            asm volatile("s_waitcnt vmcnt(0)" ::: "memory");
        } else {
            XB_SPIN(xb_ld(&bar[XB_XGEN(b.x)]) == gen, bar);
            __builtin_amdgcn_fence(__ATOMIC_ACQUIRE, "agent");
            asm volatile("s_waitcnt vmcnt(0)" ::: "memory");
        }
    }
    __syncthreads();
}

__device__ __forceinline__ float wave_sum(float v) {
#pragma unroll
    for (int o = 1; o < 64; o <<= 1) v += __shfl_xor(v, o);
    return v;
}
__device__ __forceinline__ void transpose_item(const float* W, int N, bf16* WT, int ldk, int k0, int n0, int rbase, LAS float* scr, int lane) {
    f32x4 t[8];
#pragma unroll
    for (int i = 0; i < 8; ++i) t[i] = *(const GAS f32x4*)(W + (size_t)(k0 + 8 * i + (lane >> 3)) * N + n0 + 4 * (lane & 7));
#pragma unroll
    for (int i = 0; i < 8; ++i) { LAS float* d = scr + (8 * i + (lane >> 3)) * 33 + 4 * (lane & 7); d[0] = t[i][0]; d[1] = t[i][1]; d[2] = t[i][2]; d[3] = t[i][3]; }
    LDS_WAIT(); asm volatile("" ::: "memory");
    const int c = lane & 7;
#pragma unroll
    for (int j = 0; j < 4; ++j) { const int n = (lane >> 3) + 8 * j; const LAS float* s = scr + (8 * c) * 33 + n;
        v4u o; o.x = pk2(s[0 * 33], s[1 * 33]); o.y = pk2(s[2 * 33], s[3 * 33]); o.z = pk2(s[4 * 33], s[5 * 33]); o.w = pk2(s[6 * 33], s[7 * 33]);
        *(GAS v4u*)(WT + (size_t)(rbase + n) * ldk + k0 + 8 * c) = o; }
    LDS_WAIT(); asm volatile("" ::: "memory");
}
struct Ptrs {
    const float *x, *norm1_g, *w_in, *lam_qk, *subln_g, *pool_w, *pool_scale, *w_out, *norm2_g, *w_gate, *w_up, *w_down, *final_g;
    float* out; bf16 *W1, *WO, *WGU, *WD, *XB, *PROJ, *MIX, *H; float* SSQ;
};
__device__ __forceinline__ void p0_prologue(const Ptrs& P, LAS unsigned char* lds, int vcu, int G, int wave, int lane) {
    LAS float* scr = (LAS float*)(lds + RING_OFF + wave * 16384);
    const int gw = vcu * NWAVES + wave, NGW = G * NWAVES;
    constexpr int I_IN = (DM / 64) * (INW / 32), I_OUT = (ATTW / 64) * (DM / 32), I_G = (DM / 64) * (DFF / 32), I_D = (DFF / 64) * (DM / 32), I_LAYER = I_IN + I_OUT + 2 * I_G + I_D;
    for (int it = gw; it < DEPTH * I_LAYER; it += NGW) {
        const int l = it / I_LAYER; int r = it % I_LAYER;
        if (r < I_IN) { const int nb = INW / 32; transpose_item(P.w_in + (size_t)l * DM * INW, INW, P.W1 + (size_t)l * INW * DM, DM, 64 * (r / nb), 32 * (r % nb), 32 * (r % nb), scr, lane); continue; } r -= I_IN;
        if (r < I_OUT) { const int nb = DM / 32; transpose_item(P.w_out + (size_t)l * DM * DM, DM, P.WO + (size_t)l * DM * DM, DM, 64 * (r / nb), 32 * (r % nb), 32 * (r % nb), scr, lane); continue; } r -= I_OUT;
        if (r < 2 * I_G) { const int up = r >= I_G; if (up) r -= I_G; const int nb = DFF / 32, n0 = 32 * (r % nb);
            transpose_item((up ? P.w_up : P.w_gate) + (size_t)l * DM * DFF, DFF, P.WGU + (size_t)l * NGU * DM, DM, 64 * (r / nb), n0, 256 * (n0 / 128) + (n0 % 128) + 128 * up, scr, lane); continue; } r -= 2 * I_G;
        { const int nb = DM / 32; transpose_item(P.w_down + (size_t)l * DFF * DM, DM, P.WD + (size_t)l * DM * DFF, DFF, 64 * (r / nb), 32 * (r % nb), 32 * (r % nb), scr, lane); }
    }
    for (int it = gw; it < DEPTH * 4 * 16 * 16; it += NGW) {
        const int l = it >> 10, g = (it >> 8) & 3, c0 = ((it >> 4) & 15) * 8, n = (it & 15) * 64 + lane;
        typedef const __attribute__((address_space(4))) float* cfp;
        cfp pw = (cfp)(P.pool_w + (size_t)l * 4 * 128 * 128 + ((size_t)g * 128 + c0) * 128); cfp sc = (cfp)(P.pool_scale + l * 512 + 128 * g);
        const GAS float* wo = (const GAS float*)(P.w_out + (size_t)l * DM * DM + (size_t)(512 + 128 * g) * DM + n);
        float acc[8];
#pragma unroll
        for (int j = 0; j < 8; ++j) acc[j] = 0.f;
#pragma unroll 16
        for (int d = 0; d < 128; ++d) { const float w = wo[(size_t)d * DM] * sc[d];
#pragma unroll
            for (int j = 0; j < 8; ++j) acc[j] = fmaf(pw[j * 128 + d], w, acc[j]); }
        v4u o; o.x = pk2(acc[0], acc[1]); o.y = pk2(acc[2], acc[3]); o.z = pk2(acc[4], acc[5]); o.w = pk2(acc[6], acc[7]);
        *(GAS v4u*)(P.WO + (size_t)l * DM * DM + (size_t)n * DM + 512 + 128 * g + c0) = o;
    }
    for (int row = gw; row < M; row += NGW) {
        const GAS f32x4* xr = (const GAS f32x4*)(P.x + (size_t)row * DM) + lane; const GAS f32x4* gr = (const GAS f32x4*)P.norm1_g + lane; float s = 0.f;
#pragma unroll
        for (int j = 0; j < 4; ++j) { const f32x4 v = xr[64 * j], gg = gr[64 * j]; s += (v.x * v.x + v.y * v.y) + (v.z * v.z + v.w * v.w);
            v2u o; o.x = pk2(v.x * gg.x, v.y * gg.y); o.y = pk2(v.z * gg.z, v.w * gg.w); *((GAS v2u*)(P.XB + (size_t)row * DM) + lane + 64 * j) = o; }
        s = wave_sum(s);
        if (lane < 4) *((GAS f32x4*)(P.SSQ + (size_t)row * NSSQ) + lane) = (f32x4){lane == 0 ? s : 0.f, 0.f, 0.f, 0.f};
    }
}
__device__ __forceinline__ void final_norm(float* outp, const float* fg, int vcu, int G, int wave, int lane) {
    const int gw = vcu * NWAVES + wave, NGW = G * NWAVES;
    for (int row = gw; row < M; row += NGW) {
        GAS f32x4* xr = (GAS f32x4*)(outp + (size_t)row * DM) + lane; const GAS f32x4* gr = (const GAS f32x4*)fg + lane;
        f32x4 v[4]; float s = 0.f;
#pragma unroll
        for (int j = 0; j < 4; ++j) { v[j] = xr[64 * j]; s += (v[j].x * v[j].x + v[j].y * v[j].y) + (v[j].z * v[j].z + v[j].w * v[j].w); }
        const float r = 1.0f / sqrtf(wave_sum(s) * (1.0f / DM) + EPS);
#pragma unroll
        for (int j = 0; j < 4; ++j) xr[64 * j] = v[j] * r * gr[64 * j];
    }
}

struct Args { const float* in[13]; float* out; unsigned char* ws; int ph_lo, ph_hi; };
typedef const __attribute__((address_space(4))) Args* kargs_t;
#define KARGS(A_) kargs_t A_ = (kargs_t)__builtin_amdgcn_kernarg_segment_ptr(); asm volatile("" : "+s"(A_))
__device__ __forceinline__ void fill_ptrs(Ptrs& P, kargs_t A) {
    unsigned char* ws = A->ws;
    P.x = A->in[0]; P.norm1_g = A->in[1]; P.w_in = A->in[2]; P.lam_qk = A->in[3]; P.subln_g = A->in[4]; P.pool_w = A->in[5]; P.pool_scale = A->in[6]; P.w_out = A->in[7];
    P.norm2_g = A->in[8]; P.w_gate = A->in[9]; P.w_up = A->in[10]; P.w_down = A->in[11]; P.final_g = A->in[12]; P.out = A->out;
    P.W1 = (bf16*)(ws + WS_W1); P.WO = (bf16*)(ws + WS_WO); P.WGU = (bf16*)(ws + WS_WGU); P.WD = (bf16*)(ws + WS_WD); P.XB = (bf16*)(ws + WS_XB);
    P.PROJ = (bf16*)(ws + WS_PROJ); P.MIX = (bf16*)(ws + WS_MIX); P.H = (bf16*)(ws + WS_H); P.SSQ = (float*)(ws + WS_SSQ);
}
__global__ void __launch_bounds__(NWAVES * 64, 2) mk_fwd(Args args) {
    extern __shared__ __attribute__((aligned(16))) unsigned char lds_raw[];
    LAS unsigned char* lds = (LAS unsigned char*)lds_raw;
    volatile LAS unsigned* MISC = (volatile LAS unsigned*)(lds + MISC_OFF);
    const int tid = threadIdx.x, lane = tid & 63, wave = __builtin_amdgcn_readfirstlane(tid >> 6);
    const int G = gridDim.x; const int bx = blockIdx.x; const int vcu = (G % 8 == 0) ? (bx % 8) * (G / 8) + bx / 8 : bx;
    for (int u = tid; u < (LDS_BYTES - LDSCTL_OFF) / 4; u += NWAVES * 64) ((LAS unsigned*)(lds + LDSCTL_OFF))[u] = 0u;
    __syncthreads();
    const int lo = args.ph_lo, hi = args.ph_hi;
    XcdBarrier bar; bar.bar = (unsigned*)(args.ws + WS_CTL) + CW_BAR; bar.x = 0; bar.st = nullptr;
    if (hi - lo > 1) bar = xcd_barrier_post((unsigned*)(args.ws + WS_CTL) + CW_BAR, MISC + 8);
#ifndef MK_EN
#define MK_EN 0xffu
#endif
#define IN(k) (lo <= (k) && (k) < hi)
#define SEAM(k) do { if (IN(k) && IN((k) + 1)) xcd_barrier(bar); } while (0)

    if (IN(0) && (MK_EN & 1u)) { KARGS(A); Ptrs P; fill_ptrs(P, A); p0_prologue(P, lds, vcu, G, wave, lane); SEAM(0); }

    for (int l = 0; l < DEPTH; ++l) {
        const int pb = 1 + 5 * l;
        if (IN(pb) && (MK_EN & 2u)) {
            KARGS(A); unsigned char* ws = A->ws;
            pg8::Gemm g{(const bf16*)(ws + WS_XB), (const bf16*)(ws + WS_W1) + (size_t)l * INW * DM, M, INW, DM}; pg8::StaticOrder S; S.init(M, INW, G, bx);
            pg8::EpiProj E{(bf16*)(ws + WS_PROJ), (const float*)(ws + WS_SSQ)};
            pg8::gemm_phase<pg8::EpiProj, pg8::StaticOrder, true, true>(lds + RING_OFF, g, S, E);
            SEAM(pb);
        }
        if (IN(pb + 1) && (MK_EN & 4u)) {
            KARGS(A); unsigned char* ws = A->ws;
            dattn::attn_pool_phase((char*)lds_raw + RING_OFF, (const bf16*)(ws + WS_PROJ), (bf16*)(ws + WS_MIX), A->in[3] + l * 256, l == 0 ? LAM0_0 : LAM0_1, A->in[4] + l * DV, vcu, G);
            SEAM(pb + 1);
        }
        if (IN(pb + 2) && (MK_EN & 8u)) {
            KARGS(A); unsigned char* ws = A->ws; float* out = A->out;
            pg8::Gemm g{(const bf16*)(ws + WS_MIX), (const bf16*)(ws + WS_WO) + (size_t)l * DM * DM, M, DM, DM}; pg8::StaticOrder S; S.init(M, DM, G, bx);
            pg8::EpiRes E{l == 0 ? A->in[0] : out, out, (bf16*)(ws + WS_XB), A->in[8] + l * DM, (float*)(ws + WS_SSQ)};
            pg8::gemm_phase<pg8::EpiRes, pg8::StaticOrder, true, true>(lds + RING_OFF, g, S, E);
            SEAM(pb + 2);
        }
        if (IN(pb + 3) && (MK_EN & 16u)) {
            KARGS(A); unsigned char* ws = A->ws;
            pg8::Gemm g{(const bf16*)(ws + WS_XB), (const bf16*)(ws + WS_WGU) + (size_t)l * NGU * DM, M, NGU, DM}; pg8::StaticOrder S; S.init(M, NGU, G, bx);
            pg8::EpiSwiglu E{(bf16*)(ws + WS_H), (const float*)(ws + WS_SSQ)};
            pg8::gemm_phase<pg8::EpiSwiglu, pg8::StaticOrder, true, true>(lds + RING_OFF, g, S, E);
            SEAM(pb + 3);
        }
        if (IN(pb + 4) && (MK_EN & 32u)) {
            KARGS(A); unsigned char* ws = A->ws; float* out = A->out;
            pg8::Gemm g{(const bf16*)(ws + WS_H), (const bf16*)(ws + WS_WD) + (size_t)l * DM * DFF, M, DM, DFF}; pg8::StaticOrder S; S.init(M, DM, G, bx);
            pg8::EpiRes E{out, out, (l + 1 < DEPTH) ? (bf16*)(ws + WS_XB) : nullptr, A->in[1] + (l + 1 < DEPTH ? (l + 1) * DM : 0), (float*)(ws + WS_SSQ)};
            pg8::gemm_phase<pg8::EpiRes, pg8::StaticOrder, true, true>(lds + RING_OFF, g, S, E);
            SEAM(pb + 4);
        }
    }
    if (IN(NPHASE - 1) && (MK_EN & 64u)) { KARGS(A); final_norm(A->out, A->in[12], vcu, G, wave, lane); }
#undef IN
#undef SEAM
}

#ifndef MK_ONE_LAUNCH
#define MK_ONE_LAUNCH 1
#endif
#ifndef MK_NAIVE_MASK
#define MK_NAIVE_MASK 0u
#endif
#if !MK_ONE_LAUNCH
constexpr size_t WS_LAM = 47 * MiB;
__global__ void __launch_bounds__(256) k_transpose(const float* __restrict__ W, int K, int N, bf16* __restrict__ WT, int ldk, int row_off, int mode) {
    __shared__ float scr_all[4][64 * 33];
    const int wave = threadIdx.x >> 6, lane = threadIdx.x & 63;
    float* scr = scr_all[wave];
    const int nblk = N / 32, nitems = (K / 64) * nblk;
    for (int item = blockIdx.x * 4 + wave; item < nitems; item += gridDim.x * 4) {
        const int kb = item / nblk, nb = item % nblk, k0 = 64 * kb, n0 = 32 * nb;
        for (int i = 0; i < 32; ++i) { const int kk = 2 * i + (lane >> 5); scr[kk * 33 + (lane & 31)] = W[(size_t)(k0 + kk) * N + n0 + (lane & 31)]; }
        __builtin_amdgcn_wave_barrier(); asm volatile("s_waitcnt lgkmcnt(0)" ::: "memory");
        const int c = lane & 7;
        const int rbase = (mode == 1) ? (256 * (n0 / 128) + (n0 % 128) + row_off) : (row_off + n0);
        for (int j = 0; j < 4; ++j) { const int n = (lane >> 3) + 8 * j; const float* s = scr + (8 * c) * 33 + n;
            uint4 o; o.x = pk2(s[0 * 33], s[1 * 33]); o.y = pk2(s[2 * 33], s[3 * 33]); o.z = pk2(s[4 * 33], s[5 * 33]); o.w = pk2(s[6 * 33], s[7 * 33]);
            *(uint4*)(WT + (size_t)(rbase + n) * ldk + k0 + 8 * c) = o; }
        asm volatile("s_waitcnt lgkmcnt(0)" ::: "memory"); __builtin_amdgcn_wave_barrier();
    }
}
__global__ void __launch_bounds__(256) k_fold_pool(const float* __restrict__ pool_w, const float* __restrict__ scale, const float* __restrict__ w_out, bf16* __restrict__ WoT) {
    const int idx = blockIdx.x * 256 + threadIdx.x;
    const int n = idx & 1023, gc = idx >> 10, g = gc >> 7, c = gc & 127;
    const float* pw = pool_w + ((size_t)g * 128 + c) * 128; const float* sc = scale + 128 * g; const float* wo = w_out + (size_t)(512 + 128 * g) * DM + n;
    float acc = 0.f;
    for (int d = 0; d < 128; ++d) acc = fmaf(pw[d] * sc[d], wo[(size_t)d * DM], acc);
    WoT[(size_t)n * DM + 512 + gc] = (bf16)f2bf(acc);
}
__global__ void k_lambda(const float* __restrict__ lam_qk, float* __restrict__ lam_out) {
    const int l = threadIdx.x; if (l >= DEPTH) return;
    const float* q = lam_qk + l * 256; float s1 = 0.f, s2 = 0.f;
    for (int i = 0; i < 64; ++i) { s1 += q[i] * q[64 + i]; s2 += q[128 + i] * q[192 + i]; }
    lam_out[l] = expf(s1) - expf(s2) + (l == 0 ? LAM0_0 : LAM0_1);
}
__global__ void __launch_bounds__(256) k_prep_x(const float* __restrict__ x, const float* __restrict__ g, bf16* __restrict__ XB, float* __restrict__ SSQ) {
    const int row = blockIdx.x * 4 + (threadIdx.x >> 6), lane = threadIdx.x & 63;
    const f32x4* xr = (const f32x4*)(x + (size_t)row * DM) + lane; const f32x4* gr = (const f32x4*)g + lane;
    float s = 0.f;
    for (int j = 0; j < 4; ++j) { const f32x4 v = xr[64 * j], gg = gr[64 * j]; s += (v.x * v.x + v.y * v.y) + (v.z * v.z + v.w * v.w);
        uint2 o; o.x = pk2(v.x * gg.x, v.y * gg.y); o.y = pk2(v.z * gg.z, v.w * gg.w); *((uint2*)(XB + (size_t)row * DM) + lane + 64 * j) = o; }
    for (int o = 1; o < 64; o <<= 1) s += __shfl_xor(s, o);
    if (lane < 4) *((f32x4*)(SSQ + (size_t)row * NSSQ) + lane) = (f32x4){lane == 0 ? s : 0.f, 0.f, 0.f, 0.f};
}
enum { EPI_PROJ = 0, EPI_RES = 1, EPI_SWIGLU = 2 };
struct EpiArgs { bf16* outb; float* outf; const float* base; const float* SSQ; int ldc; int pad; };
template <int EPI, int NB> __global__ void __launch_bounds__(256) k_gemm(const bf16* __restrict__ A, const bf16* __restrict__ Bt, int K, EpiArgs e) {
    const int lane = threadIdx.x & 63, w = threadIdx.x >> 6, fr = lane & 15, fq = lane >> 4;
    const int m0 = blockIdx.y * 128 + 64 * (w >> 1), n0 = blockIdx.x * (NB * 128) + 64 * (w & 1);
    f32x4 acc[NB][4][4];
    for (int g = 0; g < NB; ++g) for (int i = 0; i < 4; ++i) for (int j = 0; j < 4; ++j) acc[g][i][j] = (f32x4){0.f, 0.f, 0.f, 0.f};
    const bf16* ap = A + (size_t)(m0 + fr) * K + 8 * fq; const bf16* bp = Bt + (size_t)(n0 + fr) * K + 8 * fq;
    for (int k0 = 0; k0 < K; k0 += 32) {
        bf16x8 af[4], bfr[NB][4];
#pragma unroll
        for (int i = 0; i < 4; ++i) af[i] = *(const bf16x8*)(ap + (size_t)(16 * i) * K + k0);
#pragma unroll
        for (int g = 0; g < NB; ++g)
#pragma unroll
            for (int j = 0; j < 4; ++j) bfr[g][j] = *(const bf16x8*)(bp + (size_t)(128 * g + 16 * j) * K + k0);
#pragma unroll
        for (int g = 0; g < NB; ++g)
#pragma unroll
            for (int i = 0; i < 4; ++i)
#pragma unroll
                for (int j = 0; j < 4; ++j) acc[g][i][j] = __builtin_amdgcn_mfma_f32_16x16x32_bf16(bfr[g][j], af[i], acc[g][i][j], 0, 0, 0);
    }
#pragma unroll
    for (int i = 0; i < 4; ++i) {
        const int row = m0 + 16 * i + fr;
        if (EPI == EPI_PROJ) {
            const float r = pg8::rstd16(e.SSQ, row);
#pragma unroll
            for (int j = 0; j < 4; ++j) { const int col = n0 + 16 * j + 4 * fq; const float s = (col < ATTW) ? r * C2 : r; const f32x4 v = acc[0][i][j] * s;
                uint2 o; o.x = pk2(v.x, v.y); o.y = pk2(v.z, v.w); *(uint2*)(e.outb + (size_t)row * e.ldc + col) = o; }
        } else if (EPI == EPI_RES) {
#pragma unroll
            for (int j = 0; j < 4; ++j) { const int col = n0 + 16 * j + 4 * fq; const f32x4 b = *(const f32x4*)(e.base + (size_t)row * e.ldc + col);
                *(f32x4*)(e.outf + (size_t)row * e.ldc + col) = b + acc[0][i][j]; }
        } else {
            const float r = pg8::rstd16(e.SSQ, row);
#pragma unroll
            for (int j = 0; j < 4; ++j) { const int col = blockIdx.x * 128 + 64 * (w & 1) + 16 * j + 4 * fq;
                const f32x4 gt = acc[0][i][j] * r, up = acc[NB - 1][i][j] * r; f32x4 h;
                for (int q = 0; q < 4; ++q) h[q] = gt[q] / (1.0f + __expf(-gt[q])) * up[q];
                uint2 o; o.x = pk2(h.x, h.y); o.y = pk2(h.z, h.w); *(uint2*)(e.outb + (size_t)row * e.ldc + col) = o; }
        }
    }
}
__global__ void __launch_bounds__(128) k_attn_naive(const bf16* __restrict__ PROJ, bf16* __restrict__ MIX, const float* __restrict__ lamp, int layer, const float* __restrict__ subln_g, float one_minus_lam0) {
    __shared__ float s1[SEQ], s2[SEQ], qv[128], red[8];
    const int tid = threadIdx.x, qpos = blockIdx.x, h = blockIdx.y, b = blockIdx.z;
    const size_t row = (size_t)b * SEQ + qpos;
    qv[tid] = bf2f(PROJ[row * INW + h * 128 + tid]);
    __syncthreads();
    float m1 = -INFINITY, m2 = -INFINITY;
    for (int j = tid; j <= qpos; j += 128) {
        const bf16* kr = PROJ + ((size_t)b * SEQ + j) * INW + ATTW + h * 128; float a1 = 0.f, a2 = 0.f;
        for (int d = 0; d < 64; ++d) { a1 += qv[d] * bf2f(kr[d]); a2 += qv[64 + d] * bf2f(kr[64 + d]); }
        s1[j] = a1; s2[j] = a2; m1 = fmaxf(m1, a1); m2 = fmaxf(m2, a2);
    }
    for (int o = 1; o < 64; o <<= 1) { m1 = fmaxf(m1, __shfl_xor(m1, o)); m2 = fmaxf(m2, __shfl_xor(m2, o)); }
    if ((tid & 63) == 0) { red[tid >> 6] = m1; red[2 + (tid >> 6)] = m2; }
    __syncthreads();
    m1 = fmaxf(red[0], red[1]); m2 = fmaxf(red[2], red[3]);
    float l1 = 0.f, l2 = 0.f;
    for (int j = tid; j <= qpos; j += 128) { const float p1 = exp2f(s1[j] - m1), p2 = exp2f(s2[j] - m2); s1[j] = p1; s2[j] = p2; l1 += p1; l2 += p2; }
    for (int o = 1; o < 64; o <<= 1) { l1 += __shfl_xor(l1, o); l2 += __shfl_xor(l2, o); }
    if ((tid & 63) == 0) { red[4 + (tid >> 6)] = l1; red[6 + (tid >> 6)] = l2; }
    __syncthreads();
    l1 = red[4] + red[5]; l2 = red[6] + red[7];
    float o1 = 0.f, o2 = 0.f;
    const bf16* vp = PROJ + (size_t)b * SEQ * INW + 2 * ATTW + h * 128 + tid;
    for (int j = 0; j <= qpos; ++j) { const float v = bf2f(vp[(size_t)j * INW]); o1 = fmaf(s1[j], v, o1); o2 = fmaf(s2[j], v, o2); }
    const float lam = lamp[layer];
    const float a = o1 / l1 - lam * (o2 / l2);
    float ss = a * a;
    for (int o = 1; o < 64; o <<= 1) ss += __shfl_xor(ss, o);
    __syncthreads();
    if ((tid & 63) == 0) red[tid >> 6] = ss;
    __syncthreads();
    ss = red[0] + red[1];
    const float y = a * (1.0f / sqrtf(ss * (1.0f / DV) + EPS)) * subln_g[tid] * one_minus_lam0;
    MIX[row * DM + h * 128 + tid] = (bf16)f2bf(y);
}
__global__ void __launch_bounds__(256) k_pool_naive(const bf16* __restrict__ PROJ, bf16* __restrict__ MIX) {
    const int idx = blockIdx.x * 256 + threadIdx.x, c = idx & 511, row = idx >> 9, t = row & (SEQ - 1), g = c >> 7, w = 2 << g;
    const int n = (t + 1 < w) ? (t + 1) : w;
    const bf16* up = PROJ + (size_t)row * INW + 3 * ATTW + c; float s = 0.f;
    for (int i = 0; i < n; ++i) s += bf2f(*(up - (size_t)i * INW));
    MIX[(size_t)row * DM + ATTW + c] = (bf16)f2bf(s / (float)n - bf2f(*up));
}
__global__ void __launch_bounds__(256) k_final(float* __restrict__ x, const float* __restrict__ g) {
    const int row = blockIdx.x * 4 + (threadIdx.x >> 6), lane = threadIdx.x & 63;
    f32x4* xr = (f32x4*)(x + (size_t)row * DM) + lane; const f32x4* gr = (const f32x4*)g + lane;
    f32x4 v[4]; float s = 0.f;
    for (int j = 0; j < 4; ++j) { v[j] = xr[64 * j]; s += (v[j].x * v[j].x + v[j].y * v[j].y) + (v[j].z * v[j].z + v[j].w * v[j].w); }
    for (int o = 1; o < 64; o <<= 1) s += __shfl_xor(s, o);
    const float r = 1.0f / sqrtf(s * (1.0f / DM) + EPS);
    for (int j = 0; j < 4; ++j) xr[64 * j] = v[j] * r * gr[64 * j];
}
static void naive_phase(int p, const Ptrs& P, unsigned char* ws, hipStream_t stream) {
    float* LAM = (float*)(ws + WS_LAM);
    if (p == 0) {
        for (int l = 0; l < DEPTH; ++l) {
            k_transpose<<<512, 256, 0, stream>>>(P.w_in + (size_t)l * DM * INW, DM, INW, P.W1 + (size_t)l * INW * DM, DM, 0, 0);
            k_transpose<<<512, 256, 0, stream>>>(P.w_out + (size_t)l * DM * DM, ATTW, DM, P.WO + (size_t)l * DM * DM, DM, 0, 0);
            k_transpose<<<512, 256, 0, stream>>>(P.w_gate + (size_t)l * DM * DFF, DM, DFF, P.WGU + (size_t)l * NGU * DM, DM, 0, 1);
            k_transpose<<<512, 256, 0, stream>>>(P.w_up + (size_t)l * DM * DFF, DM, DFF, P.WGU + (size_t)l * NGU * DM, DM, 128, 1);
            k_transpose<<<512, 256, 0, stream>>>(P.w_down + (size_t)l * DFF * DM, DFF, DM, P.WD + (size_t)l * DM * DFF, DFF, 0, 0);
            k_fold_pool<<<512 * 1024 / 256, 256, 0, stream>>>(P.pool_w + (size_t)l * 4 * 128 * 128, P.pool_scale + l * 512, P.w_out + (size_t)l * DM * DM, P.WO + (size_t)l * DM * DM);
        }
        k_prep_x<<<M / 4, 256, 0, stream>>>(P.x, P.norm1_g, P.XB, P.SSQ);
        return;
    }
    if (p == NPHASE - 1) { k_final<<<M / 4, 256, 0, stream>>>(P.out, P.final_g); return; }
    const int l = (p - 1) / 5, k = (p - 1) % 5;
    if (k == 0) { EpiArgs e{P.PROJ, nullptr, nullptr, P.SSQ, INW, 0}; k_gemm<EPI_PROJ, 1><<<dim3(INW / 128, M / 128), 256, 0, stream>>>(P.XB, P.W1 + (size_t)l * INW * DM, DM, e); }
    if (k == 1) { k_lambda<<<1, 64, 0, stream>>>(P.lam_qk, LAM);
        k_attn_naive<<<dim3(SEQ, NH, BATCH), 128, 0, stream>>>(P.PROJ, P.MIX, LAM, l, P.subln_g + l * DV, 1.0f - (l == 0 ? LAM0_0 : LAM0_1));
        k_pool_naive<<<M * 512 / 256, 256, 0, stream>>>(P.PROJ, P.MIX); }
    if (k == 2) { EpiArgs e{nullptr, P.out, l == 0 ? P.x : P.out, nullptr, DM, 0}; k_gemm<EPI_RES, 1><<<dim3(DM / 128, M / 128), 256, 0, stream>>>(P.MIX, P.WO + (size_t)l * DM * DM, DM, e);
        k_prep_x<<<M / 4, 256, 0, stream>>>(P.out, P.norm2_g + l * DM, P.XB, P.SSQ); }
    if (k == 3) { EpiArgs e{P.H, nullptr, nullptr, P.SSQ, DFF, 0}; k_gemm<EPI_SWIGLU, 2><<<dim3(DFF / 128, M / 128), 256, 0, stream>>>(P.XB, P.WGU + (size_t)l * NGU * DM, DM, e); }
    if (k == 4) { EpiArgs e{nullptr, P.out, P.out, nullptr, DM, 0}; k_gemm<EPI_RES, 1><<<dim3(DM / 128, M / 128), 256, 0, stream>>>(P.H, P.WD + (size_t)l * DM * DFF, DFF, e);
        if (l + 1 < DEPTH) k_prep_x<<<M / 4, 256, 0, stream>>>(P.out, P.norm1_g + (l + 1) * DM, P.XB, P.SSQ); }
}
#endif

extern "C" void kernel_launch(void* const* d_in, const int* in_sizes, int n_in, void* d_out, int out_size, void* d_ws, size_t ws_size, hipStream_t stream) {
    static int grid = 0;
    if (grid == 0) {
        if (n_in != 13 || in_sizes[0] != M * DM || out_size != M * DM || ws_size < WS_END) { fprintf(stderr, "kernel_launch: unexpected shapes (n_in %d, ws %zu); nothing launched\n", n_in, ws_size); grid = -1; return; }
        int dev = 0, cus = 0, per_cu = 0;
        if (hipGetDevice(&dev) != hipSuccess || hipDeviceGetAttribute(&cus, hipDeviceAttributeMultiprocessorCount, dev) != hipSuccess) { fprintf(stderr, "kernel_launch: device query failed\n"); grid = -1; return; }
        if (hipFuncSetAttribute((const void*)mk_fwd, hipFuncAttributeMaxDynamicSharedMemorySize, LDS_BYTES) != hipSuccess) { fprintf(stderr, "kernel_launch: hipFuncSetAttribute failed\n"); grid = -1; return; }
        if (hipOccupancyMaxActiveBlocksPerMultiprocessor(&per_cu, (const void*)mk_fwd, NWAVES * 64, LDS_BYTES) != hipSuccess || per_cu < 1)
            fprintf(stderr, "kernel_launch: note: occupancy query reports %d workgroups per CU\n", per_cu);
        (void)hipGetLastError();
        grid = cus;
    }
    if (grid < 0) return;
    if (hipMemsetAsync((char*)d_ws + WS_CTL, 0, CTL_ZERO_BYTES, stream) != hipSuccess) { fprintf(stderr, "kernel_launch: hipMemsetAsync failed\n"); return; }
    Args a{};
    for (int i = 0; i < 13; ++i) a.in[i] = (const float*)d_in[i];
    a.out = (float*)d_out; a.ws = (unsigned char*)d_ws;
#if MK_ONE_LAUNCH
    a.ph_lo = 0; a.ph_hi = NPHASE;
    hipLaunchKernelGGL(mk_fwd, dim3(grid), dim3(NWAVES * 64), LDS_BYTES, stream, a);
#else
    unsigned char* ws = (unsigned char*)d_ws;
    Ptrs P;
    P.x = a.in[0]; P.norm1_g = a.in[1]; P.w_in = a.in[2]; P.lam_qk = a.in[3]; P.subln_g = a.in[4]; P.pool_w = a.in[5]; P.pool_scale = a.in[6]; P.w_out = a.in[7];
    P.norm2_g = a.in[8]; P.w_gate = a.in[9]; P.w_up = a.in[10]; P.w_down = a.in[11]; P.final_g = a.in[12]; P.out = a.out;
    P.W1 = (bf16*)(ws + WS_W1); P.WO = (bf16*)(ws + WS_WO); P.WGU = (bf16*)(ws + WS_WGU); P.WD = (bf16*)(ws + WS_WD); P.XB = (bf16*)(ws + WS_XB);
    P.PROJ = (bf16*)(ws + WS_PROJ); P.MIX = (bf16*)(ws + WS_MIX); P.H = (bf16*)(ws + WS_H); P.SSQ = (float*)(ws + WS_SSQ);
    for (int p = 0; p < NPHASE; ++p) {
        if ((MK_NAIVE_MASK >> p) & 1u) { naive_phase(p, P, ws, stream); continue; }
        a.ph_lo = p; a.ph_hi = p + 1;
        hipLaunchKernelGGL(mk_fwd, dim3(grid), dim3(NWAVES * 64), LDS_BYTES, stream, a);
#ifdef MK_DUP_MASK
        if ((MK_DUP_MASK >> p) & 1u) hipLaunchKernelGGL(mk_fwd, dim3(grid), dim3(NWAVES * 64), LDS_BYTES, stream, a);
#endif
    }
#endif
    const hipError_t le = hipPeekAtLastError();
    if (le != hipSuccess) fprintf(stderr, "kernel_launch: launch failed: %s (grid %d)\n", hipGetErrorName(le), grid);
}
```

```cpp
#include <hip/hip_runtime.h>
#include <cstdio>
#include <cstdint>
#include <cmath>

constexpr int BATCH = 8, SEQ = 2048, DM = 1024, DEPTH = 2, M = BATCH * SEQ;
constexpr int NH = 4, DV = 128, ATTW = 512, INW = 2048, DFF = 2816, NGU = 2 * DFF;
constexpr float EPS = 1e-5f;
constexpr float C2 = 0.125f * 1.4426950408889634f;
constexpr float LAM0_0 = 0.2f, LAM0_1 = 0.35550906759096926f;
constexpr int NSSQ = 16;

#define MK_ONE_LAUNCH 1
#define MK_NAIVE_MASK 0u
namespace pg8 {
#define PG8_LAS __attribute__((address_space(3)))
typedef unsigned short bf16_t;
typedef short bf16x8 __attribute__((ext_vector_type(8)));
typedef float f32x4 __attribute__((ext_vector_type(4)));
typedef unsigned u32x4 __attribute__((ext_vector_type(4)));
constexpr int BM = 256, BK = 64, HALF = 128, HTB = HALF * BK * 2  , STAGE_BYTES = 8 * HTB, NXCD = 8, WGM = 8;

__host__ __device__ __forceinline__ int lds_byte(int r, int c) { const int st = (r >> 4) * 2 + (c >> 5), rr = r & 15, cc = c & 31, ob = rr * 64 + cc * 2; return st * 1024 + (ob ^ (((ob >> 9) & 1) << 5)); }
__host__ __device__ __forceinline__ void stage_rc(int b, int& R, int& C) { const int st = b / 1024, sb = b % 1024, swz = sb ^ (((sb >> 9) & 1) << 5); R = (st >> 1) * 16 + swz / 64; C = (st & 1) * 32 + (swz % 64) / 2; }
__host__ __device__ __forceinline__ int perm32(int rho) { const int n = rho >> 4, i = rho & 15; return 8 * (i >> 2) + 4 * n + (i & 3); }

struct Unit { int pm, pn; };
struct Gemm { const bf16_t* A; const bf16_t* Bt; int M, N, K; };

struct StaticOrder {
    int nM, nN, nwg, G, c;
    __host__ __device__ void init(int M, int N, int G_, int c_) { nM = M / BM; nN = N / BM; nwg = nM * nN; G = G_; c = c_; }
    __host__ __device__ bool next(int i, Unit& u) const {
        const long L = (long)i * G + c; if (L >= nwg) return false;
        int wgid = (int)L; { const int q = nwg / NXCD, r = nwg % NXCD, xcd = wgid % NXCD, off = wgid / NXCD; wgid = (xcd < r ? xcd * (q + 1) : r * (q + 1) + (xcd - r) * q) + off; }
        const int nig = WGM * nN, gid = wgid / nig, fm = gid * WGM, gsz = (nM - fm) < WGM ? (nM - fm) : WGM;
        u.pm = fm + ((wgid % nig) % gsz); u.pn = (wgid % nig) / gsz; return true;
    }
    __device__ __forceinline__ void a_ready(const Unit&) const {}
    __device__ __forceinline__ void done(const Unit&) const {}
};

__device__ __forceinline__ unsigned cvt_pk_bf16(float lo, float hi) { unsigned r; asm volatile("v_cvt_pk_bf16_f32 %0, %1, %2" : "=v"(r) : "v"(lo), "v"(hi)); return r; }
__device__ __forceinline__ float rstd16(const float* SSQ, int row) {
    const f32x4* p = (const f32x4*)(SSQ + (size_t)row * NSSQ); const f32x4 a = p[0], b = p[1], c = p[2], d = p[3];
    const float s = ((a[0] + a[1]) + (a[2] + a[3])) + ((b[0] + b[1]) + (b[2] + b[3])) + ((c[0] + c[1]) + (c[2] + c[3])) + ((d[0] + d[1]) + (d[2] + d[3]));
    return 1.0f / sqrtf(s * (1.0f / DM) + EPS);
}
struct EpiProj {
    static constexpr bool PERM = true, AFTER_DRAIN = false;
    bf16_t* O; const float* SSQ;
    __device__ __forceinline__ void operator()(const f32x4 (&acc)[2][2][4][2], const Unit& u, int wr, int wc, int fr, int fq) const {
        const int row0 = u.pm * BM + wr * 64 + fr, col0 = u.pn * BM + wc * 32 + 8 * fq;
        const float qs = (u.pn < 2) ? C2 : 1.0f;
#pragma unroll
        for (int ai = 0; ai < 2; ++ai)
#pragma unroll
            for (int m = 0; m < 4; ++m) { const int row = row0 + ai * HALF + m * 16; const float r = rstd16(SSQ, row) * qs; bf16_t* rowp = O + (size_t)row * INW + col0;
#pragma unroll
                for (int bj = 0; bj < 2; ++bj) { const f32x4 v0 = acc[ai][bj][m][0] * r, v1 = acc[ai][bj][m][1] * r;
                    u32x4 w; w.x = cvt_pk_bf16(v0[0], v0[1]); w.y = cvt_pk_bf16(v0[2], v0[3]); w.z = cvt_pk_bf16(v1[0], v1[1]); w.w = cvt_pk_bf16(v1[2], v1[3]);
                    *(u32x4*)(rowp + bj * HALF) = w; } }
    }
};
struct EpiSwiglu {
    static constexpr bool PERM = true, AFTER_DRAIN = false;
    bf16_t* O; const float* SSQ;
    __device__ __forceinline__ void operator()(const f32x4 (&acc)[2][2][4][2], const Unit& u, int wr, int wc, int fr, int fq) const {
        const int row0 = u.pm * BM + wr * 64 + fr, col0 = u.pn * HALF + wc * 32 + 8 * fq;
#pragma unroll
        for (int ai = 0; ai < 2; ++ai)
#pragma unroll
            for (int m = 0; m < 4; ++m) { const int row = row0 + ai * HALF + m * 16; const float r = rstd16(SSQ, row); float hv[8];
#pragma unroll
                for (int n = 0; n < 2; ++n)
#pragma unroll
                    for (int q = 0; q < 4; ++q) { const float g = acc[ai][0][m][n][q] * r, up = acc[ai][1][m][n][q] * r;
                        hv[4 * n + q] = g * __builtin_amdgcn_rcpf(1.0f + __builtin_amdgcn_exp2f(-1.4426950408889634f * g)) * up; }
                u32x4 w; w.x = cvt_pk_bf16(hv[0], hv[1]); w.y = cvt_pk_bf16(hv[2], hv[3]); w.z = cvt_pk_bf16(hv[4], hv[5]); w.w = cvt_pk_bf16(hv[6], hv[7]);
                *(u32x4*)(O + (size_t)row * DFF + col0) = w; }
    }
};
struct EpiRes {
    static constexpr bool PERM = true, AFTER_DRAIN = false;
    const float* basef; bf16_t* XS; float* outf; float* SSQ;
    __device__ __forceinline__ void operator()(const f32x4 (&acc)[2][2][4][2], const Unit& u, int wr, int wc, int fr, int fq) const {
        const int row0 = u.pm * BM + wr * 64 + fr, col0 = u.pn * BM + wc * 32 + 8 * fq;
#pragma unroll
        for (int ai = 0; ai < 2; ++ai)
#pragma unroll
            for (int m = 0; m < 4; ++m) { const int row = row0 + ai * HALF + m * 16; const size_t off = (size_t)row * DM + col0; float ss = 0.f;
#pragma unroll
                for (int bj = 0; bj < 2; ++bj) { f32x4 x0, x1;
                    if (basef) { x0 = *(const f32x4*)(basef + off + bj * HALF); x1 = *(const f32x4*)(basef + off + bj * HALF + 4); }
                    else { const u32x4 b = *(const u32x4*)(XS + off + bj * HALF);
                        x0 = (f32x4){__uint_as_float(b.x << 16), __uint_as_float(b.x & 0xffff0000u), __uint_as_float(b.y << 16), __uint_as_float(b.y & 0xffff0000u)};
                        x1 = (f32x4){__uint_as_float(b.z << 16), __uint_as_float(b.z & 0xffff0000u), __uint_as_float(b.w << 16), __uint_as_float(b.w & 0xffff0000u)}; }
                    x0 += acc[ai][bj][m][0]; x1 += acc[ai][bj][m][1];
                    ss += ((x0[0] * x0[0] + x0[1] * x0[1]) + (x0[2] * x0[2] + x0[3] * x0[3])) + ((x1[0] * x1[0] + x1[1] * x1[1]) + (x1[2] * x1[2] + x1[3] * x1[3]));
                    if (outf) { *(f32x4*)(outf + off + bj * HALF) = x0; *(f32x4*)(outf + off + bj * HALF + 4) = x1; }
                    else { u32x4 w; w.x = cvt_pk_bf16(x0[0], x0[1]); w.y = cvt_pk_bf16(x0[2], x0[3]); w.z = cvt_pk_bf16(x1[0], x1[1]); w.w = cvt_pk_bf16(x1[2], x1[3]);
                        *(u32x4*)(XS + off + bj * HALF) = w; } }
                ss += __shfl_xor(ss, 16); ss += __shfl_xor(ss, 32);
                if (fq == 0) SSQ[(size_t)row * NSSQ + 4 * u.pn + wc] = ss;
                if (m & 1) asm volatile("" ::: "memory"); }
    }
};

template <class Epi, class Sched, bool ALIGN_EPI = false, bool SP2 = false>
__device__ __forceinline__ void gemm_phase(PG8_LAS unsigned char* lds, const Gemm g, const Sched& S, const Epi& E) {
    int tid_o = threadIdx.x; asm volatile("" : "+v"(tid_o));
    const int tid = tid_o, wid = __builtin_amdgcn_readfirstlane(tid >> 6), lane = tid & 63, wr = wid >> 2, wc = wid & 3, fr = lane & 15, fq = lane >> 4;
    const int K = g.K, nt = K / BK;
    unsigned voffA[2], voffB[2];
#pragma unroll
    for (int i = 0; i < 2; ++i) { int R, C; stage_rc(tid * 16 + i * 8192, R, C); const int Rb = Epi::PERM ? ((R & ~31) + perm32(R & 31)) : R;
        voffA[i] = (unsigned)(R * K + C) * 2u; voffB[i] = (unsigned)(Rb * K + C) * 2u; }
    const size_t kstep = (size_t)(BK * 2);
    const size_t hstep = (size_t)HALF * K * 2;
    const size_t tstep = 2 * hstep;
    const unsigned ldsw = (unsigned)wid * 1024u;
    const int aoff = lds_byte(wr * 64 + fr, fq * 8), boff = lds_byte(wc * 32 + fr, fq * 8);
#define PG8_SA(b, h) (((b) * 2 + (h)) * HTB)
#define PG8_SB(b, h) ((4 + (b) * 2 + (h)) * HTB)
#define PG8_STAGE(bufoff, gbase, voff) do { _Pragma("unroll") for (int _i = 0; _i < 2; ++_i) \
        __builtin_amdgcn_global_load_lds((const unsigned*)((const char*)(gbase) + (voff)[_i]), (PG8_LAS unsigned*)(lds + (bufoff) + ldsw + _i * 8192), 16, 0, 0); } while (0)
#define PG8_LDA(dst, b, h) do { _Pragma("unroll") for (int m = 0; m < 4; ++m) _Pragma("unroll") for (int k = 0; k < 2; ++k) dst[m][k] = *(const PG8_LAS bf16x8*)(lds + PG8_SA(b, h) + aoff + m * 2048 + k * 1024); } while (0)
#define PG8_LDB(dst, b, h) do { _Pragma("unroll") for (int n = 0; n < 2; ++n) _Pragma("unroll") for (int k = 0; k < 2; ++k) dst[n][k] = *(const PG8_LAS bf16x8*)(lds + PG8_SB(b, h) + boff + n * 2048 + k * 1024); } while (0)
#define PG8_MMA(ai, bj, At, Bt) do { __builtin_amdgcn_s_setprio(1); _Pragma("unroll") for (int m = 0; m < 4; ++m) _Pragma("unroll") for (int n = 0; n < 2; ++n) _Pragma("unroll") for (int k = 0; k < 2; ++k) \
        acc[ai][bj][m][n] = __builtin_amdgcn_mfma_f32_16x16x32_bf16(Bt[n][k], At[m][k], acc[ai][bj][m][n], 0, 0, 0); __builtin_amdgcn_s_setprio(0); } while (0)
#define PG8_WAIT_V(n) asm volatile("s_waitcnt vmcnt(" #n ")" ::: "memory")
#define PG8_WAIT_L(n) asm volatile("s_waitcnt lgkmcnt(" #n ")" ::: "memory")
#define PG8_BAR __builtin_amdgcn_s_barrier()
#define PG8_SCHED __builtin_amdgcn_sched_barrier(0)
    Unit cur, nxt; int ui = 0;
    if (!S.next(0, cur)) return;
    f32x4 acc[2][2][4][2];
#pragma unroll
    for (int a = 0; a < 2; ++a)
#pragma unroll
        for (int b = 0; b < 2; ++b)
#pragma unroll
            for (int m = 0; m < 4; ++m)
#pragma unroll
                for (int n = 0; n < 2; ++n) acc[a][b][m][n] = (f32x4){0.f, 0.f, 0.f, 0.f};
    bf16x8 At[4][2], B0[2][2], B1[2][2];
    const char* cA = (const char*)g.A + (size_t)cur.pm * tstep; const char* cB = (const char*)g.Bt + (size_t)cur.pn * tstep;
    S.a_ready(cur);
    if constexpr (SP2) {
        PG8_STAGE(PG8_SB(0, 0), cB, voffB); PG8_STAGE(PG8_SB(0, 1), cB + hstep, voffB); PG8_STAGE(PG8_SA(0, 0), cA, voffA); PG8_STAGE(PG8_SA(0, 1), cA + hstep, voffA);
        if (wr == 1) PG8_BAR;
        PG8_WAIT_V(2); PG8_BAR;
        PG8_STAGE(PG8_SB(1, 0), cB + kstep, voffB); PG8_STAGE(PG8_SA(1, 0), cA + kstep, voffA); PG8_STAGE(PG8_SB(1, 1), cB + hstep + kstep, voffB);
        PG8_WAIT_V(6); PG8_BAR;
    } else {
        PG8_STAGE(PG8_SB(0, 0), cB, voffB); PG8_STAGE(PG8_SA(0, 0), cA, voffA); PG8_STAGE(PG8_SB(0, 1), cB + hstep, voffB); PG8_STAGE(PG8_SA(0, 1), cA + hstep, voffA);
        if (wr == 1) PG8_BAR;
        PG8_WAIT_V(4); PG8_BAR;
        PG8_STAGE(PG8_SB(1, 0), cB + kstep, voffB); PG8_STAGE(PG8_SA(1, 0), cA + kstep, voffA); PG8_STAGE(PG8_SB(1, 1), cB + hstep + kstep, voffB);
        PG8_WAIT_V(6); PG8_BAR;
    }
    for (;;) {
        const bool has_next = S.next(ui + 1, nxt);
        const char* nA = has_next ? (const char*)g.A + (size_t)nxt.pm * tstep : cA; const char* nB = has_next ? (const char*)g.Bt + (size_t)nxt.pn * tstep : cB;
        for (int t = 0; t < nt; t += 2) {
            const bool last = (t == nt - 2);
            const char* a1 = cA + (size_t)(t + 1) * kstep;
            const char* a2 = last ? nA : cA + (size_t)(t + 2) * kstep; const char* b2 = last ? nB : cB + (size_t)(t + 2) * kstep;
            const char* a3 = a2 + kstep; const char* b3 = b2 + kstep;
            if (last && has_next) S.a_ready(nxt);
            if constexpr (SP2) {
            PG8_LDB(B0, 0, 0); PG8_LDB(B1, 0, 1); PG8_SCHED; PG8_LDA(At, 0, 0); PG8_STAGE(PG8_SA(1, 1), a1 + hstep, voffA);
            PG8_WAIT_V(8); PG8_WAIT_L(0); PG8_BAR; PG8_MMA(0, 0, At, B0); PG8_MMA(0, 1, At, B1); PG8_BAR; PG8_SCHED;
            PG8_LDA(At, 0, 1); PG8_STAGE(PG8_SB(0, 0), b2, voffB); PG8_STAGE(PG8_SB(0, 1), b2 + hstep, voffB); PG8_STAGE(PG8_SA(0, 0), a2, voffA);
            PG8_WAIT_V(8); PG8_WAIT_L(0); PG8_BAR; PG8_MMA(1, 0, At, B0); PG8_MMA(1, 1, At, B1); PG8_BAR; PG8_SCHED;
            PG8_LDB(B0, 1, 0); PG8_LDB(B1, 1, 1); PG8_SCHED; PG8_LDA(At, 1, 0); PG8_STAGE(PG8_SA(0, 1), a2 + hstep, voffA);
            PG8_WAIT_V(8); PG8_WAIT_L(0); PG8_BAR; PG8_MMA(0, 0, At, B0); PG8_MMA(0, 1, At, B1); PG8_BAR; PG8_SCHED;
            PG8_LDA(At, 1, 1); PG8_STAGE(PG8_SB(1, 0), b3, voffB); PG8_STAGE(PG8_SB(1, 1), b3 + hstep, voffB); PG8_STAGE(PG8_SA(1, 0), a3, voffA);
            PG8_WAIT_V(8); PG8_WAIT_L(0); PG8_BAR; PG8_MMA(1, 0, At, B0); PG8_MMA(1, 1, At, B1); PG8_BAR; PG8_SCHED;
            } else {
            PG8_LDB(B0, 0, 0); PG8_SCHED; PG8_LDA(At, 0, 0); PG8_STAGE(PG8_SA(1, 1), a1 + hstep, voffA);
            PG8_WAIT_L(8); PG8_BAR; PG8_WAIT_L(0); PG8_MMA(0, 0, At, B0); PG8_BAR; PG8_SCHED;
            PG8_LDB(B1, 0, 1); PG8_STAGE(PG8_SB(0, 0), b2, voffB);
            PG8_BAR; PG8_WAIT_L(0); PG8_MMA(0, 1, At, B1); PG8_BAR;
            PG8_LDA(At, 0, 1); PG8_STAGE(PG8_SA(0, 0), a2, voffA);
            PG8_BAR; PG8_WAIT_L(0); PG8_MMA(1, 0, At, B0); PG8_BAR; PG8_SCHED;
            PG8_STAGE(PG8_SB(0, 1), b2 + hstep, voffB);
            PG8_WAIT_V(6); PG8_BAR; PG8_MMA(1, 1, At, B1); PG8_BAR;
            PG8_LDB(B0, 1, 0); PG8_SCHED; PG8_LDA(At, 1, 0); PG8_STAGE(PG8_SA(0, 1), a2 + hstep, voffA);
            PG8_WAIT_L(8); PG8_BAR; PG8_WAIT_L(0); PG8_MMA(0, 0, At, B0); PG8_BAR; PG8_SCHED;
            PG8_LDB(B1, 1, 1); PG8_STAGE(PG8_SB(1, 0), b3, voffB);
            PG8_BAR; PG8_WAIT_L(0); PG8_MMA(0, 1, At, B1); PG8_BAR;
            PG8_LDA(At, 1, 1); PG8_STAGE(PG8_SA(1, 0), a3, voffA);
            PG8_BAR; PG8_WAIT_L(0); PG8_MMA(1, 0, At, B0); PG8_BAR; PG8_SCHED;
            PG8_STAGE(PG8_SB(1, 1), b3 + hstep, voffB);
            PG8_WAIT_V(6); PG8_BAR; PG8_MMA(1, 1, At, B1); PG8_BAR;
            }
        }
        if constexpr (ALIGN_EPI) { if (wr == 0) PG8_BAR; }
        if constexpr (!Epi::AFTER_DRAIN) { E(acc, cur, wr, wc, fr, fq); S.done(cur); }
        if (!has_next) break;
#pragma unroll
        for (int a = 0; a < 2; ++a)
#pragma unroll
            for (int b = 0; b < 2; ++b)
#pragma unroll
                for (int m = 0; m < 4; ++m)
#pragma unroll
                    for (int n = 0; n < 2; ++n) acc[a][b][m][n] = (f32x4){0.f, 0.f, 0.f, 0.f};
        cur = nxt; cA = nA; cB = nB; ++ui;
        if constexpr (ALIGN_EPI) { if (wr == 1) PG8_BAR; }
    }
    PG8_WAIT_V(0);
    if constexpr (!ALIGN_EPI) { if (wr == 0) PG8_BAR; }
    PG8_BAR;
    if constexpr (Epi::AFTER_DRAIN) { E.fused(acc, cur, wr, wc, fr, fq, lds, wid, lane); S.done(cur); }
#undef PG8_SA
#undef PG8_SB
#undef PG8_STAGE
#undef PG8_LDA
#undef PG8_LDB
#undef PG8_MMA
#undef PG8_WAIT_V
#undef PG8_WAIT_L
#undef PG8_BAR
#undef PG8_SCHED
}
}
namespace dattn {
typedef unsigned short bf16_t;
typedef short bf16x8 __attribute__((ext_vector_type(8)));
typedef short s16x4 __attribute__((ext_vector_type(4)));
typedef float f32x16 __attribute__((ext_vector_type(16)));
typedef float f32x4 __attribute__((ext_vector_type(4)));
typedef unsigned u32x4 __attribute__((ext_vector_type(4)));
typedef short v4i16_t __attribute__((ext_vector_type(4)));
#define DA_LAS __attribute__((address_space(3)))
typedef DA_LAS const char* lds_cptr;
constexpr int QB = 128, KVBLK = 64, PITCH = INW, NSLOT_K = 3, NSLOT_V = 4, SLOTB = 16384;
constexpr int LDS_K = 0, LDS_V = NSLOT_K * SLOTB, LDS_WS = (NSLOT_K + NSLOT_V) * SLOTB, LDS_BYTES = LDS_WS + 8 * 256;
constexpr int LDS_XCH = 0;
constexpr float THR = 6.0f;
__device__ __forceinline__ int crow(int r, int hi) { return (r & 3) + 8 * (r >> 2) + 4 * hi; }
__device__ __forceinline__ void dma16(unsigned voff, __amdgpu_buffer_rsrc_t srd, unsigned soff, unsigned lds_dst) { unsigned keep;
    asm volatile("s_mov_b32 %0, m0\n\ts_mov_b32 m0, %4\n\ts_nop 4\n\tbuffer_load_dwordx4 %1, %2, %3 offen lds\n\ts_mov_b32 m0, %0" : "=&s"(keep) : "v"(voff), "s"(srd), "s"(soff), "s"(lds_dst) : "memory"); }
typedef float f32x2_t __attribute__((ext_vector_type(2))); typedef __bf16 bf16x2_t __attribute__((ext_vector_type(2)));
__device__ __forceinline__ unsigned cvtpk_s(float lo, float hi) { f32x2_t v = {lo, hi}; bf16x2_t b = __builtin_convertvector(v, bf16x2_t); return __builtin_bit_cast(unsigned, b); }
__device__ __forceinline__ s16x4 vtr(lds_cptr p) { return __builtin_bit_cast(s16x4, __builtin_amdgcn_ds_read_tr16_b64_v4i16((DA_LAS v4i16_t*)p)); }
__device__ __forceinline__ float max3f(float a, float b, float c) { float r; asm("v_max3_f32 %0, %1, %2, %3" : "=v"(r) : "v"(a), "v"(b), "v"(c)); return r; }
__device__ __forceinline__ float max2f(float a, float b) { float r; asm("v_max_f32_e32 %0, %1, %2" : "=v"(r) : "v"(a), "v"(b)); return r; }
#define DA_WAIT_BAR(N) asm volatile("s_waitcnt vmcnt(" #N ") lgkmcnt(0)\n\ts_barrier" ::: "memory")
#define DA_MFMA(a, b, c) __builtin_amdgcn_mfma_f32_32x32x16_bf16(a, b, c, 0, 0, 0)

__device__ __forceinline__ void qk_tile(f32x16& p0, f32x16& p1, lds_cptr kp, const bf16x8 (&qr)[4], const f32x16& negm) {
#pragma unroll
    for (int d0 = 0; d0 < 4; ++d0) { const bf16x8 b0 = *(const DA_LAS bf16x8*)(kp + d0 * 2048), b1 = *(const DA_LAS bf16x8*)(kp + d0 * 2048 + 512);
        if (d0 == 0) { p0 = DA_MFMA(b0, qr[0], negm); p1 = DA_MFMA(b1, qr[0], negm); } else { p0 = DA_MFMA(b0, qr[d0], p0); p1 = DA_MFMA(b1, qr[d0], p1); } }
}
__device__ __forceinline__ void pv_tile(f32x16 (&o)[4], lds_cptr vp, const u32x4 (&pw)[4]) {
#pragma unroll
    for (int db = 0; db < 4; ++db)
#pragma unroll
        for (int ks = 0; ks < 4; ++ks) { const s16x4 lo = vtr(vp + db * 4096 + ks * 1024), hv = vtr(vp + db * 4096 + ks * 1024 + 512);
            const bf16x8 vf = (bf16x8){lo[0], lo[1], lo[2], lo[3], hv[0], hv[1], hv[2], hv[3]};
            o[db] = DA_MFMA(__builtin_bit_cast(bf16x8, pw[ks]), vf, o[db]);
            if (ks == 3) __builtin_amdgcn_sched_barrier(0); }
}
template <bool MASK> __device__ __forceinline__ void softmax_tile(f32x16& p0, f32x16& p1, u32x4 (&pw)[4], f32x16 (&o)[4], f32x16& negm, float& m, float& l, bool first, int kb, int qrel, int hi, int r32, DA_LAS float* wsf) {
    if (MASK) {
#pragma unroll
        for (int r = 0; r < 16; ++r) { const int kv = kb + (r & 3) + 8 * (r >> 2); if (kv > qrel) p0[r] = -INFINITY; if (kv + 32 > qrel) p1[r] = -INFINITY; } }
    float a = max3f(p0[0], p0[1], p1[0]), b = max3f(p0[2], p0[3], p1[1]); a = max3f(a, p1[2], p1[3]);
#pragma unroll
    for (int r = 4; r < 16; r += 4) { a = max3f(a, p0[r], p0[r + 1]); b = max3f(b, p0[r + 2], p0[r + 3]); a = max3f(a, p1[r], p1[r + 1]); b = max3f(b, p1[r + 2], p1[r + 3]); }
    float rm = max2f(a, b);
    { auto rr = __builtin_amdgcn_permlane32_swap(__float_as_uint(rm), __float_as_uint(rm), false, false); rm = max2f(__uint_as_float(rr[0]), __uint_as_float(rr[1])); }
    if (first || __any(rm > THR)) {
        const float dl = first ? rm : fmaxf(rm, 0.f); m += dl;
#pragma unroll
        for (int r = 0; r < 16; ++r) { p0[r] -= dl; p1[r] -= dl; }
#pragma unroll
        for (int r = 0; r < 16; ++r) negm[r] = -m;
        if (!first) { const float f = __builtin_amdgcn_exp2f(-dl); l *= f;
            if (hi == 0) wsf[r32] = f;
#pragma unroll
            for (int r = 0; r < 16; ++r) { const float fr_ = wsf[crow(r, hi)];
#pragma unroll
                for (int db = 0; db < 4; ++db) o[db][r] *= fr_; } }
    }
    float sacc = 0.f;
#pragma unroll
    for (int r = 0; r < 16; ++r) { p0[r] = __builtin_amdgcn_exp2f(p0[r]); p1[r] = __builtin_amdgcn_exp2f(p1[r]); sacc += p0[r] + p1[r]; }
    l += sacc;
#pragma unroll
    for (int i = 0; i < 4; ++i) { pw[0][i] = cvtpk_s(p0[2 * i], p0[2 * i + 1]); pw[1][i] = cvtpk_s(p0[8 + 2 * i], p0[9 + 2 * i]); pw[2][i] = cvtpk_s(p1[2 * i], p1[2 * i + 1]); pw[3][i] = cvtpk_s(p1[8 + 2 * i], p1[9 + 2 * i]); }
}

__device__ __forceinline__ void attn_unit(int b, int h, int qb, const bf16_t* PROJ, bf16_t* MIX, float lam, const float* sg, float oml0, char* shm) {
    int tid_o = threadIdx.x; asm volatile("" : "+v"(tid_o));
    const int tid = tid_o, lane = tid & 63, r32 = lane & 31, hi = lane >> 5;
    const int wid = __builtin_amdgcn_readfirstlane(tid >> 6), c = wid >> 2, wq = wid & 3;
    const long rowbase = (long)b * SEQ; const int q0 = qb * QB;
    const bf16_t* Qw = PROJ + (rowbase + q0 + wq * 32) * PITCH + h * 128 + c * 64;
    const unsigned lds0 = (unsigned)(uintptr_t)shm;
    const lds_cptr shm3 = (lds_cptr)shm;
    DA_LAS float* wsf = (DA_LAS float*)(shm3 + LDS_WS) + wid * 64;
    const __amdgpu_buffer_rsrc_t srd = __builtin_amdgcn_make_buffer_rsrc((void*)(PROJ + rowbase * PITCH), (short)0, SEQ * PITCH * 2, 0x00020000);
    const unsigned kvoff = (unsigned)(lane * PITCH + ATTW + h * 128 + wid * 8) * 2u;
    const unsigned vvoff = (unsigned)((16 * (wid & 3) + (lane >> 2)) * PITCH + 2 * ATTW + h * 128 + (wid >> 2) * 32 + (lane & 3) * 8) * 2u;
    const unsigned kdst = lds0 + LDS_K + wid * 1024, vdst = lds0 + LDS_V + wid * 1024;
#define DA_RFL(x) ((unsigned)__builtin_amdgcn_readfirstlane((int)(x)))
#define DA_DMA_TILE(t, kslot, vslot) do { const unsigned so_ = DA_RFL((unsigned)(t) * (unsigned)(KVBLK * PITCH * 2)); \
        dma16(kvoff, srd, so_, DA_RFL(kdst + (kslot))); dma16(kvoff, srd, so_ + 128u, DA_RFL(kdst + (kslot) + 8192)); \
        dma16(vvoff, srd, so_, DA_RFL(vdst + (vslot))); dma16(vvoff, srd, so_ + 128u, DA_RFL(vdst + (vslot) + 8192)); } while (0)
    const int NT = 2 * (qb + 1);
    DA_DMA_TILE(0, 0, 0); DA_DMA_TILE(1, SLOTB, SLOTB);
    bf16x8 qr[4];
#pragma unroll
    for (int d0 = 0; d0 < 4; ++d0) qr[d0] = *(const bf16x8*)(Qw + (long)r32 * PITCH + d0 * 16 + hi * 8);
    float m = 0.f, l = 0.f;
    f32x16 o[4], negm = f32x16{};
#pragma unroll
    for (int i = 0; i < 4; ++i) o[i] = f32x16{};
    int ks_cur = 0, ks_nxt = SLOTB, ks_free = 2 * SLOTB;
    int vs_prev = 3 * SLOTB, vs_cur = 0, vs_nxt = SLOTB, vs_free = 2 * SLOTB;
    const lds_cptr kp0 = shm3 + LDS_K + c * 8192 + hi * 1024 + r32 * 16;
    const lds_cptr vp0 = shm3 + LDS_V + ((lane >> 4) & 1) * 32 + (lane & 3) * 8 + (4 * hi + ((lane & 15) >> 2)) * 64;
    const int qrel = wq * 32 + r32;
    u32x4 pw[4];
#define DA_STEP(ROLE, MASKED, t) do { \
        if ((t) + 1 < NT) { DA_WAIT_BAR(4); } else { DA_WAIT_BAR(0); }     \
        if ((t) + 2 < NT) DA_DMA_TILE((t) + 2, ks_free, vs_free); \
        f32x16 p0, p1; \
        if (ROLE == 0) { \
            qk_tile(p0, p1, kp0 + ks_cur, qr, negm); \
            softmax_tile<MASKED>(p0, p1, pw, o, negm, m, l, (t) == 0, 64 * ((t) - (NT - 2)) + 4 * hi, qrel, hi, r32, wsf); \
            pv_tile(o, vp0 + vs_cur, pw); \
        } else { \
            if ((t) > 0) pv_tile(o, vp0 + vs_prev, pw); \
            qk_tile(p0, p1, kp0 + ks_cur, qr, negm); \
            softmax_tile<MASKED>(p0, p1, pw, o, negm, m, l, (t) == 0, 64 * ((t) - (NT - 2)) + 4 * hi, qrel, hi, r32, wsf); \
        } \
        { const int tk = ks_cur; ks_cur = ks_nxt; ks_nxt = ks_free; ks_free = tk; const int tv = vs_prev; vs_prev = vs_cur; vs_cur = vs_nxt; vs_nxt = vs_free; vs_free = tv; } \
    } while (0)
    if (c == 0) {
        int t = 0;
        for (; t < NT - 2; ++t) DA_STEP(0, false, t);
        DA_STEP(0, true, t); ++t;
        DA_STEP(0, true, t);
    } else {
        int t = 0;
        for (; t < NT - 2; ++t) DA_STEP(1, false, t);
        DA_STEP(1, true, t); ++t;
        DA_STEP(1, true, t);
        pv_tile(o, vp0 + vs_prev, pw);
    }
#undef DA_STEP
    { auto rr = __builtin_amdgcn_permlane32_swap(__float_as_uint(l), __float_as_uint(l), false, false); l = __uint_as_float(rr[0]) + __uint_as_float(rr[1]); }
    if (hi == 0) wsf[32 + r32] = (c == 1 ? lam : 1.0f) / l;
    asm volatile("s_waitcnt lgkmcnt(0)\n\ts_barrier" ::: "memory");
    DA_LAS float* xch = (DA_LAS float*)(shm3 + LDS_XCH) + wq * 4096;
    if (c == 1) {
#pragma unroll
        for (int r = 0; r < 16; ++r) { const float rl = wsf[32 + crow(r, hi)];
#pragma unroll
            for (int db = 0; db < 4; ++db) xch[(db * 16 + r) * 64 + lane] = o[db][r] * rl; }
    }
    asm volatile("s_waitcnt lgkmcnt(0)\n\ts_barrier" ::: "memory");
    if (c == 0) {
#pragma unroll
        for (int r = 0; r < 16; ++r) { const float rl = wsf[32 + crow(r, hi)];
#pragma unroll
            for (int db = 0; db < 4; ++db) o[db][r] = o[db][r] * rl - xch[(db * 16 + r) * 64 + lane]; }
        asm volatile("s_waitcnt lgkmcnt(0)" ::: "memory");
#pragma unroll
        for (int r = 0; r < 16; ++r)
#pragma unroll
            for (int db = 0; db < 4; ++db) xch[crow(r, hi) * 128 + db * 32 + r32] = o[db][r];
        asm volatile("s_waitcnt lgkmcnt(0)" ::: "memory");
        const int dcol = 8 * (lane & 15);
        const f32x4 g0 = *(const f32x4*)(sg + dcol), g1 = *(const f32x4*)(sg + dcol + 4);
        bf16_t* Ow = MIX + (rowbase + q0 + wq * 32) * DM + h * 128 + dcol;
#pragma unroll
        for (int i = 0; i < 8; ++i) { const int row = 4 * i + (lane >> 4);
            const f32x4 v0 = *(const DA_LAS f32x4*)(xch + row * 128 + dcol), v1 = *(const DA_LAS f32x4*)(xch + row * 128 + dcol + 4);
            float ss = ((v0[0] * v0[0] + v0[1] * v0[1]) + (v0[2] * v0[2] + v0[3] * v0[3])) + ((v1[0] * v1[0] + v1[1] * v1[1]) + (v1[2] * v1[2] + v1[3] * v1[3]));
            ss += __shfl_xor(ss, 1); ss += __shfl_xor(ss, 2); ss += __shfl_xor(ss, 4); ss += __shfl_xor(ss, 8);
            const float rs = oml0 / sqrtf(ss * (1.0f / DV) + EPS);
            const f32x4 y0 = v0 * g0 * rs, y1 = v1 * g1 * rs;
            u32x4 w; w.x = cvtpk_s(y0[0], y0[1]); w.y = cvtpk_s(y0[2], y0[3]); w.z = cvtpk_s(y1[0], y1[1]); w.w = cvtpk_s(y1[2], y1[3]);
            *(u32x4*)(Ow + (long)row * DM) = w; }
    }
    asm volatile("s_waitcnt lgkmcnt(0)\n\ts_barrier" ::: "memory");
#undef DA_DMA_TILE
#undef DA_RFL
}
template <int W> __device__ __forceinline__ void pool_rows4(const bf16_t* PROJ, bf16_t* MIX, int row0, int g, int lane) {
    const int row = row0 + (lane >> 4), c8 = g * 128 + (lane & 15) * 8, t = row & (SEQ - 1);
    const bf16_t* up = PROJ + (size_t)row * INW + 3 * ATTW + c8;
    u32x4 v[W];
#pragma unroll
    for (int i = 0; i < W; ++i) v[i] = *(const u32x4*)(up - (size_t)(i <= t ? i : t) * INW);
    float s[8];
#pragma unroll
    for (int j = 0; j < 8; ++j) s[j] = 0.f;
#pragma unroll
    for (int i = 0; i < W; ++i) { const float msk = (i <= t) ? 1.0f : 0.0f;
#pragma unroll
        for (int j = 0; j < 4; ++j) { s[2 * j] = fmaf(msk, __uint_as_float(v[i][j] << 16), s[2 * j]); s[2 * j + 1] = fmaf(msk, __uint_as_float(v[i][j] & 0xffff0000u), s[2 * j + 1]); } }
    const float rn = 1.0f / (float)((t + 1 < W) ? (t + 1) : W); u32x4 o;
#pragma unroll
    for (int j = 0; j < 4; ++j) o[j] = cvtpk_s(s[2 * j] * rn - __uint_as_float(v[0][j] << 16), s[2 * j + 1] * rn - __uint_as_float(v[0][j] & 0xffff0000u));
    *(u32x4*)(MIX + (size_t)row * DM + ATTW + c8) = o;
}
__device__ __forceinline__ void attn_pool_phase(char* lds, const bf16_t* PROJ, bf16_t* MIX, const float* lam_qk, float lam0, const float* sg, int vcu, int G) {
    const int lane = threadIdx.x & 63;
    float s1 = lam_qk[lane] * lam_qk[64 + lane], s2 = lam_qk[128 + lane] * lam_qk[192 + lane];
#pragma unroll
    for (int o = 1; o < 64; o <<= 1) { s1 += __shfl_xor(s1, o); s2 += __shfl_xor(s2, o); }
    const float lam = expf(s1) - expf(s2) + lam0;
#ifndef MK_ATT_REP
#define MK_ATT_REP 1
#endif
#ifndef MK_POOL_REP
#define MK_POOL_REP 1
#endif
    for (int rep = 0; rep < MK_ATT_REP; ++rep)
    for (int v = vcu; v < BATCH * NH * 8; v += G) { const int bh = v >> 3, s = v & 7;
#pragma unroll 1
        for (int u = 0; u < 2; ++u) attn_unit(bh >> 2, bh & 3, u ? 15 - s : s, PROJ, MIX, lam, sg, 1.0f - lam0, lds); }
    for (int rep = 0; rep < MK_POOL_REP; ++rep)
    { const int wave = __builtin_amdgcn_readfirstlane((int)threadIdx.x >> 6);
      for (int it = vcu * 8 + wave; it < M; it += G * 8) { const int g = it & 3, row0 = (it >> 2) * 4;
          if (g == 0) pool_rows4<2>(PROJ, MIX, row0, 0, lane); else if (g == 1) pool_rows4<4>(PROJ, MIX, row0, 1, lane);
          else if (g == 2) pool_rows4<8>(PROJ, MIX, row0, 2, lane); else pool_rows4<16>(PROJ, MIX, row0, 3, lane); } }
}
#undef DA_WAIT_BAR
#undef DA_MFMA
}

constexpr int NWAVES = 8;
constexpr int NPHASE = 2 + 5 * DEPTH;
constexpr size_t MiB = 1u << 20;
constexpr size_t WS_CTL = 0, CTL_ZERO_BYTES = 65536;
constexpr size_t WS_W1 = 1 * MiB;
constexpr size_t WS_WO = 9 * MiB;
constexpr size_t WS_WGU = 13 * MiB;
constexpr size_t WS_WD = 35 * MiB;
constexpr size_t WS_SSQ = 46 * MiB;
constexpr size_t WS_XB = 48 * MiB;
constexpr size_t WS_PROJ = 80 * MiB;
constexpr size_t WS_MIX = 144 * MiB;
constexpr size_t WS_H = 80 * MiB;
constexpr size_t WS_END = 176 * MiB;
static_assert(WS_H + (size_t)M * DFF * 2 <= WS_END && WS_MIX + (size_t)M * DM * 2 <= WS_END && WS_SSQ + (size_t)M * NSSQ * 4 <= WS_XB, "ws map");
constexpr int CW_BAR = 1024;
constexpr int RING_OFF = 0, RING_BYTES = 131072;
constexpr int LDSCTL_OFF = RING_BYTES, MISC_OFF = LDSCTL_OFF + 320;
constexpr int LDS_BYTES = 147456;
static_assert(MISC_OFF + 128 <= LDS_BYTES && dattn::LDS_BYTES <= RING_BYTES && pg8::STAGE_BYTES <= RING_BYTES, "LDS map");

#define GAS __attribute__((address_space(1)))
#define LAS __attribute__((address_space(3)))
typedef unsigned short bf16;
typedef unsigned v4u __attribute__((ext_vector_type(4)));
typedef unsigned v2u __attribute__((ext_vector_type(2)));
typedef float f32x4 __attribute__((ext_vector_type(4)));
typedef short bf16x8 __attribute__((ext_vector_type(8)));
typedef GAS unsigned gu32;
#define RLX_AGENT __ATOMIC_RELAXED, __HIP_MEMORY_SCOPE_AGENT
#define LDS_WAIT() asm volatile("s_waitcnt lgkmcnt(0)" ::: "memory")
__device__ __forceinline__ unsigned f2bf(float f) { unsigned u = __builtin_bit_cast(unsigned, f); return (u + 0x7fffu + ((u >> 16) & 1u)) >> 16; }
__device__ __forceinline__ unsigned pk2(float lo, float hi) { return f2bf(lo) | (f2bf(hi) << 16); }
__device__ __forceinline__ float bf2f(bf16 b) { return __builtin_bit_cast(float, (unsigned)b << 16); }

#define XB_TMO      128
#define XB_XCNT(j)  (256  + 64 * (j))
#define XB_XSUB(j)  (1280 + 64 * (j))
#define XB_XGEN(j)  (2304 + 64 * (j))
#define XB_TOP      3328
#define XB_TOPGEN   3392
#define XCD_BAR_WORDS 3456
#define XB_SPIN_CAP (1u << 18)

__device__ __forceinline__ unsigned xb_ld(unsigned* p)              { return __hip_atomic_load(p, __ATOMIC_RELAXED, __HIP_MEMORY_SCOPE_AGENT); }
__device__ __forceinline__ unsigned xb_add(unsigned* p, unsigned v) { return __hip_atomic_fetch_add(p, v, __ATOMIC_RELAXED, __HIP_MEMORY_SCOPE_AGENT); }
__device__ __forceinline__ unsigned xb_xcc_id() { return (unsigned)__builtin_amdgcn_s_getreg((3 << 11) | 20) & 0xFu; }
#define XB_SPIN(cond, bar) do { unsigned _sp = 0; while (cond) { __builtin_amdgcn_s_sleep(1); \
    if ((++_sp & 255u) == 0u) { if (xb_ld(&(bar)[XB_TMO])) break; if (_sp > XB_SPIN_CAP) { atomicAdd(&(bar)[XB_TMO], 1u); break; } } } } while (0)

struct XcdBarrier {
    unsigned* bar; unsigned x;
    volatile LAS unsigned* st;
};

__device__ __forceinline__ XcdBarrier xcd_barrier_post(unsigned* bar, volatile LAS unsigned* st) {
    XcdBarrier b; b.bar = bar; b.x = xb_xcc_id(); b.st = st;
    if (threadIdx.x == 0) (void)xb_add(&bar[XB_XCNT(b.x)], 1u);
    return b;
}
__device__ __forceinline__ void xcd_barrier_complete(unsigned* bar, unsigned x, unsigned& nloc, unsigned& nx) {
    const unsigned G = gridDim.x * gridDim.y * gridDim.z;
    unsigned sum, cnt, mine, sp = 0u;
    for (;;) {
        sum = 0u; cnt = 0u; mine = 0u;
#pragma unroll
        for (unsigned j = 0; j < 16; ++j) { const unsigned c = xb_ld(&bar[XB_XCNT(j)]); sum += c; cnt += (c > 0u) ? 1u : 0u; mine = (j == x) ? c : mine; }
        if (sum == G) break;
        __builtin_amdgcn_s_sleep(1);
        if ((++sp & 255u) == 0u) { if (xb_ld(&bar[XB_TMO])) break; if (sp > XB_SPIN_CAP) { atomicAdd(&bar[XB_TMO], 1u); break; } }
    }
    nloc = mine > 0u ? mine : 1u; nx = cnt > 0u ? cnt : 1u;
}

__device__ __forceinline__ void xcd_barrier(const XcdBarrier& b) {
    asm volatile("s_waitcnt vmcnt(0)" ::: "memory");
    __syncthreads();
    if (threadIdx.x == 0) {
        unsigned* bar = b.bar;
        __builtin_amdgcn_s_waitcnt(0);
        unsigned nloc = b.st[0], nx = b.st[1];
        if (nloc == 0u) { xcd_barrier_complete(bar, b.x, nloc, nx); b.st[0] = nloc; b.st[1] = nx; }
        const unsigned old = xb_add(&bar[XB_XSUB(b.x)], 1u);
        const unsigned gen = old / nloc;
        if (old + 1u == (gen + 1u) * nloc) {
            __builtin_amdgcn_fence(__ATOMIC_RELEASE, "agent");
            asm volatile("s_waitcnt vmcnt(0)" ::: "memory");
            const unsigned og = xb_add(&bar[XB_TOP], 1u);
            const unsigned tg = og / nx;
            if (og + 1u == (tg + 1u) * nx) xb_add(&bar[XB_TOPGEN], 1u);
            else XB_SPIN(xb_ld(&bar[XB_TOPGEN]) == tg, bar);
            __builtin_amdgcn_fence(__ATOMIC_ACQUIRE, "agent");
            xb_add(&bar[XB_XGEN(b.x)], 1u);
            asm volatile("s_waitcnt vmcnt(0)" ::: "memory");
        } else {
            XB_SPIN(xb_ld(&bar[XB_XGEN(b.x)]) == gen, bar);
            __builtin_amdgcn_fence(__ATOMIC_ACQUIRE, "agent");
            asm volatile("s_waitcnt vmcnt(0)" ::: "memory");
        }
    }
    __syncthreads();
}

__device__ __forceinline__ float wave_sum(float v) {
#pragma unroll
    for (int o = 1; o < 64; o <<= 1) v += __shfl_xor(v, o);
    return v;
}
__device__ __forceinline__ void transpose_item(const float* W, int N, bf16* WT, int ldk, int k0, int n0, int rbase, const float* gain, LAS float* scr, int lane) {
    f32x4 t[8];
#pragma unroll
    for (int i = 0; i < 8; ++i) t[i] = *(const GAS f32x4*)(W + (size_t)(k0 + 8 * i + (lane >> 3)) * N + n0 + 4 * (lane & 7));
    if (gain) {
#pragma unroll
        for (int i = 0; i < 8; ++i) t[i] *= gain[k0 + 8 * i + (lane >> 3)]; }
#pragma unroll
    for (int i = 0; i < 8; ++i) { LAS float* d = scr + (8 * i + (lane >> 3)) * 33 + 4 * (lane & 7); d[0] = t[i][0]; d[1] = t[i][1]; d[2] = t[i][2]; d[3] = t[i][3]; }
    LDS_WAIT(); asm volatile("" ::: "memory");
    const int c = lane & 7;
#pragma unroll
    for (int j = 0; j < 4; ++j) { const int n = (lane >> 3) + 8 * j; const LAS float* s = scr + (8 * c) * 33 + n;
        v4u o; o.x = pk2(s[0 * 33], s[1 * 33]); o.y = pk2(s[2 * 33], s[3 * 33]); o.z = pk2(s[4 * 33], s[5 * 33]); o.w = pk2(s[6 * 33], s[7 * 33]);
        *(GAS v4u*)(WT + (size_t)(rbase + n) * ldk + k0 + 8 * c) = o; }
    LDS_WAIT(); asm volatile("" ::: "memory");
}
struct Ptrs {
    const float *x, *norm1_g, *w_in, *lam_qk, *subln_g, *pool_w, *pool_scale, *w_out, *norm2_g, *w_gate, *w_up, *w_down, *final_g;
    float* out; bf16 *W1, *WO, *WGU, *WD, *XB, *PROJ, *MIX, *H; float* SSQ;
};
__device__ __forceinline__ void p0_prologue(const Ptrs& P, LAS unsigned char* lds, int vcu, int G, int wave, int lane) {
    LAS float* scr = (LAS float*)(lds + RING_OFF + wave * 16384);
    const int gw = vcu * NWAVES + wave, NGW = G * NWAVES;
    constexpr int I_IN = (DM / 64) * (INW / 32), I_OUT = (ATTW / 64) * (DM / 32), I_G = (DM / 64) * (DFF / 32), I_D = (DFF / 64) * (DM / 32), I_LAYER = I_IN + I_OUT + 2 * I_G + I_D;
    for (int it = gw; it < DEPTH * I_LAYER; it += NGW) {
        const int l = it / I_LAYER; int r = it % I_LAYER;
        if (r < I_IN) { const int nb = INW / 32; transpose_item(P.w_in + (size_t)l * DM * INW, INW, P.W1 + (size_t)l * INW * DM, DM, 64 * (r / nb), 32 * (r % nb), 32 * (r % nb), P.norm1_g + l * DM, scr, lane); continue; } r -= I_IN;
        if (r < I_OUT) { const int nb = DM / 32; transpose_item(P.w_out + (size_t)l * DM * DM, DM, P.WO + (size_t)l * DM * DM, DM, 64 * (r / nb), 32 * (r % nb), 32 * (r % nb), nullptr, scr, lane); continue; } r -= I_OUT;
        if (r < 2 * I_G) { const int up = r >= I_G; if (up) r -= I_G; const int nb = DFF / 32, n0 = 32 * (r % nb);
            transpose_item((up ? P.w_up : P.w_gate) + (size_t)l * DM * DFF, DFF, P.WGU + (size_t)l * NGU * DM, DM, 64 * (r / nb), n0, 256 * (n0 / 128) + (n0 % 128) + 128 * up, P.norm2_g + l * DM, scr, lane); continue; } r -= 2 * I_G;
        { const int nb = DM / 32; transpose_item(P.w_down + (size_t)l * DFF * DM, DM, P.WD + (size_t)l * DM * DFF, DFF, 64 * (r / nb), 32 * (r % nb), 32 * (r % nb), nullptr, scr, lane); }
    }
    for (int it = gw; it < DEPTH * 4 * 16 * 16; it += NGW) {
        const int l = it >> 10, g = (it >> 8) & 3, c0 = ((it >> 4) & 15) * 8, n = (it & 15) * 64 + lane;
        typedef const __attribute__((address_space(4))) float* cfp;
        cfp pw = (cfp)(P.pool_w + (size_t)l * 4 * 128 * 128 + ((size_t)g * 128 + c0) * 128); cfp sc = (cfp)(P.pool_scale + l * 512 + 128 * g);
        const GAS float* wo = (const GAS float*)(P.w_out + (size_t)l * DM * DM + (size_t)(512 + 128 * g) * DM + n);
        float acc[8];
#pragma unroll
        for (int j = 0; j < 8; ++j) acc[j] = 0.f;
#pragma unroll 16
        for (int d = 0; d < 128; ++d) { const float w = wo[(size_t)d * DM] * sc[d];
#pragma unroll
            for (int j = 0; j < 8; ++j) acc[j] = fmaf(pw[j * 128 + d], w, acc[j]); }
        v4u o; o.x = pk2(acc[0], acc[1]); o.y = pk2(acc[2], acc[3]); o.z = pk2(acc[4], acc[5]); o.w = pk2(acc[6], acc[7]);
        *(GAS v4u*)(P.WO + (size_t)l * DM * DM + (size_t)n * DM + 512 + 128 * g + c0) = o;
    }
    for (int row = gw; row < M; row += NGW) {
        const GAS f32x4* xr = (const GAS f32x4*)(P.x + (size_t)row * DM) + lane; float s = 0.f;
#pragma unroll
        for (int j = 0; j < 4; ++j) { const f32x4 v = xr[64 * j]; s += (v.x * v.x + v.y * v.y) + (v.z * v.z + v.w * v.w);
            v2u o; o.x = pk2(v.x, v.y); o.y = pk2(v.z, v.w); *((GAS v2u*)(P.XB + (size_t)row * DM) + lane + 64 * j) = o; }
        s = wave_sum(s);
        if (lane < 4) *((GAS f32x4*)(P.SSQ + (size_t)row * NSSQ) + lane) = (f32x4){lane == 0 ? s : 0.f, 0.f, 0.f, 0.f};
    }
}
__device__ __forceinline__ void final_norm(float* outp, const float* fg, int vcu, int G, int wave, int lane) {
    const int gw = vcu * NWAVES + wave, NGW = G * NWAVES;
    for (int row = gw; row < M; row += NGW) {
        GAS f32x4* xr = (GAS f32x4*)(outp + (size_t)row * DM) + lane; const GAS f32x4* gr = (const GAS f32x4*)fg + lane;
        f32x4 v[4]; float s = 0.f;
#pragma unroll
        for (int j = 0; j < 4; ++j) { v[j] = xr[64 * j]; s += (v[j].x * v[j].x + v[j].y * v[j].y) + (v[j].z * v[j].z + v[j].w * v[j].w); }
        const float r = 1.0f / sqrtf(wave_sum(s) * (1.0f / DM) + EPS);
#pragma unroll
        for (int j = 0; j < 4; ++j) xr[64 * j] = v[j] * r * gr[64 * j];
    }
}

struct Args { const float* in[13]; float* out; unsigned char* ws; int ph_lo, ph_hi; };
typedef const __attribute__((address_space(4))) Args* kargs_t;
#define KARGS(A_) kargs_t A_ = (kargs_t)__builtin_amdgcn_kernarg_segment_ptr(); asm volatile("" : "+s"(A_))
__device__ __forceinline__ void fill_ptrs(Ptrs& P, kargs_t A) {
    unsigned char* ws = A->ws;
    P.x = A->in[0]; P.norm1_g = A->in[1]; P.w_in = A->in[2]; P.lam_qk = A->in[3]; P.subln_g = A->in[4]; P.pool_w = A->in[5]; P.pool_scale = A->in[6]; P.w_out = A->in[7];
    P.norm2_g = A->in[8]; P.w_gate = A->in[9]; P.w_up = A->in[10]; P.w_down = A->in[11]; P.final_g = A->in[12]; P.out = A->out;
    P.W1 = (bf16*)(ws + WS_W1); P.WO = (bf16*)(ws + WS_WO); P.WGU = (bf16*)(ws + WS_WGU); P.WD = (bf16*)(ws + WS_WD); P.XB = (bf16*)(ws + WS_XB);
    P.PROJ = (bf16*)(ws + WS_PROJ); P.MIX = (bf16*)(ws + WS_MIX); P.H = (bf16*)(ws + WS_H); P.SSQ = (float*)(ws + WS_SSQ);
}
__global__ void __launch_bounds__(NWAVES * 64, 2) mk_fwd(Args args) {
    extern __shared__ __attribute__((aligned(16))) unsigned char lds_raw[];
    LAS unsigned char* lds = (LAS unsigned char*)lds_raw;
    volatile LAS unsigned* MISC = (volatile LAS unsigned*)(lds + MISC_OFF);
    const int tid = threadIdx.x, lane = tid & 63, wave = __builtin_amdgcn_readfirstlane(tid >> 6);
    const int G = gridDim.x; const int bx = blockIdx.x; const int vcu = (G % 8 == 0) ? (bx % 8) * (G / 8) + bx / 8 : bx;
    for (int u = tid; u < (LDS_BYTES - LDSCTL_OFF) / 4; u += NWAVES * 64) ((LAS unsigned*)(lds + LDSCTL_OFF))[u] = 0u;
    __syncthreads();
    const int lo = args.ph_lo, hi = args.ph_hi;
    XcdBarrier bar; bar.bar = (unsigned*)(args.ws + WS_CTL) + CW_BAR; bar.x = 0; bar.st = nullptr;
    if (hi - lo > 1) bar = xcd_barrier_post((unsigned*)(args.ws + WS_CTL) + CW_BAR, MISC + 8);
#ifndef MK_EN
#define MK_EN 0xffu
#endif
#define IN(k) (lo <= (k) && (k) < hi)
#define SEAM(k) do { if (IN(k) && IN((k) + 1)) xcd_barrier(bar); } while (0)

    if (IN(0) && (MK_EN & 1u)) { KARGS(A); Ptrs P; fill_ptrs(P, A); p0_prologue(P, lds, vcu, G, wave, lane); SEAM(0); }

    for (int l = 0; l < DEPTH; ++l) {
        const int pb = 1 + 5 * l;
        if (IN(pb) && (MK_EN & 2u)) {
            KARGS(A); unsigned char* ws = A->ws;
            pg8::Gemm g{(const bf16*)(ws + WS_XB), (const bf16*)(ws + WS_W1) + (size_t)l * INW * DM, M, INW, DM}; pg8::StaticOrder S; S.init(M, INW, G, bx);
            pg8::EpiProj E{(bf16*)(ws + WS_PROJ), (const float*)(ws + WS_SSQ)};
            pg8::gemm_phase<pg8::EpiProj, pg8::StaticOrder, true, true>(lds + RING_OFF, g, S, E);
            SEAM(pb);
        }
        if (IN(pb + 1) && (MK_EN & 4u)) {
            KARGS(A); unsigned char* ws = A->ws;
            dattn::attn_pool_phase((char*)lds_raw + RING_OFF, (const bf16*)(ws + WS_PROJ), (bf16*)(ws + WS_MIX), A->in[3] + l * 256, l == 0 ? LAM0_0 : LAM0_1, A->in[4] + l * DV, vcu, G);
            SEAM(pb + 1);
        }
        if (IN(pb + 2) && (MK_EN & 8u)) {
            KARGS(A); unsigned char* ws = A->ws;
            pg8::Gemm g{(const bf16*)(ws + WS_MIX), (const bf16*)(ws + WS_WO) + (size_t)l * DM * DM, M, DM, DM}; pg8::StaticOrder S; S.init(M, DM, G, bx);
            pg8::EpiRes E{l == 0 ? A->in[0] : nullptr, (bf16*)(ws + WS_XB), nullptr, (float*)(ws + WS_SSQ)};
            pg8::gemm_phase<pg8::EpiRes, pg8::StaticOrder, true, true>(lds + RING_OFF, g, S, E);
            SEAM(pb + 2);
        }
        if (IN(pb + 3) && (MK_EN & 16u)) {
            KARGS(A); unsigned char* ws = A->ws;
            pg8::Gemm g{(const bf16*)(ws + WS_XB), (const bf16*)(ws + WS_WGU) + (size_t)l * NGU * DM, M, NGU, DM}; pg8::StaticOrder S; S.init(M, NGU, G, bx);
            pg8::EpiSwiglu E{(bf16*)(ws + WS_H), (const float*)(ws + WS_SSQ)};
            pg8::gemm_phase<pg8::EpiSwiglu, pg8::StaticOrder, true, true>(lds + RING_OFF, g, S, E);
            SEAM(pb + 3);
        }
        if (IN(pb + 4) && (MK_EN & 32u)) {
            KARGS(A); unsigned char* ws = A->ws; float* out = A->out;
            pg8::Gemm g{(const bf16*)(ws + WS_H), (const bf16*)(ws + WS_WD) + (size_t)l * DM * DFF, M, DM, DFF}; pg8::StaticOrder S; S.init(M, DM, G, bx);
            pg8::EpiRes E{nullptr, (bf16*)(ws + WS_XB), (l + 1 < DEPTH) ? nullptr : out, (float*)(ws + WS_SSQ)};
            pg8::gemm_phase<pg8::EpiRes, pg8::StaticOrder, true, true>(lds + RING_OFF, g, S, E);
            SEAM(pb + 4);
        }
    }
    if (IN(NPHASE - 1) && (MK_EN & 64u)) { KARGS(A); final_norm(A->out, A->in[12], vcu, G, wave, lane); }
#undef IN
#undef SEAM
}

#ifndef MK_ONE_LAUNCH
#define MK_ONE_LAUNCH 1
#endif
#ifndef MK_NAIVE_MASK
#define MK_NAIVE_MASK 0u
#endif
#if !MK_ONE_LAUNCH
constexpr size_t WS_LAM = 47 * MiB;
__global__ void __launch_bounds__(256) k_transpose(const float* __restrict__ W, int K, int N, bf16* __restrict__ WT, int ldk, int row_off, int mode) {
    __shared__ float scr_all[4][64 * 33];
    const int wave = threadIdx.x >> 6, lane = threadIdx.x & 63;
    float* scr = scr_all[wave];
    const int nblk = N / 32, nitems = (K / 64) * nblk;
    for (int item = blockIdx.x * 4 + wave; item < nitems; item += gridDim.x * 4) {
        const int kb = item / nblk, nb = item % nblk, k0 = 64 * kb, n0 = 32 * nb;
        for (int i = 0; i < 32; ++i) { const int kk = 2 * i + (lane >> 5); scr[kk * 33 + (lane & 31)] = W[(size_t)(k0 + kk) * N + n0 + (lane & 31)]; }
        __builtin_amdgcn_wave_barrier(); asm volatile("s_waitcnt lgkmcnt(0)" ::: "memory");
        const int c = lane & 7;
        const int rbase = (mode == 1) ? (256 * (n0 / 128) + (n0 % 128) + row_off) : (row_off + n0);
        for (int j = 0; j < 4; ++j) { const int n = (lane >> 3) + 8 * j; const float* s = scr + (8 * c) * 33 + n;
            uint4 o; o.x = pk2(s[0 * 33], s[1 * 33]); o.y = pk2(s[2 * 33], s[3 * 33]); o.z = pk2(s[4 * 33], s[5 * 33]); o.w = pk2(s[6 * 33], s[7 * 33]);
            *(uint4*)(WT + (size_t)(rbase + n) * ldk + k0 + 8 * c) = o; }
        asm volatile("s_waitcnt lgkmcnt(0)" ::: "memory"); __builtin_amdgcn_wave_barrier();
    }
}
__global__ void __launch_bounds__(256) k_fold_pool(const float* __restrict__ pool_w, const float* __restrict__ scale, const float* __restrict__ w_out, bf16* __restrict__ WoT) {
    const int idx = blockIdx.x * 256 + threadIdx.x;
    const int n = idx & 1023, gc = idx >> 10, g = gc >> 7, c = gc & 127;
    const float* pw = pool_w + ((size_t)g * 128 + c) * 128; const float* sc = scale + 128 * g; const float* wo = w_out + (size_t)(512 + 128 * g) * DM + n;
    float acc = 0.f;
    for (int d = 0; d < 128; ++d) acc = fmaf(pw[d] * sc[d], wo[(size_t)d * DM], acc);
    WoT[(size_t)n * DM + 512 + gc] = (bf16)f2bf(acc);
}
__global__ void k_lambda(const float* __restrict__ lam_qk, float* __restrict__ lam_out) {
    const int l = threadIdx.x; if (l >= DEPTH) return;
    const float* q = lam_qk + l * 256; float s1 = 0.f, s2 = 0.f;
    for (int i = 0; i < 64; ++i) { s1 += q[i] * q[64 + i]; s2 += q[128 + i] * q[192 + i]; }
    lam_out[l] = expf(s1) - expf(s2) + (l == 0 ? LAM0_0 : LAM0_1);
}
__global__ void __launch_bounds__(256) k_prep_x(const float* __restrict__ x, const float* __restrict__ g, bf16* __restrict__ XB, float* __restrict__ SSQ) {
    const int row = blockIdx.x * 4 + (threadIdx.x >> 6), lane = threadIdx.x & 63;
    const f32x4* xr = (const f32x4*)(x + (size_t)row * DM) + lane; const f32x4* gr = (const f32x4*)g + lane;
    float s = 0.f;
    for (int j = 0; j < 4; ++j) { const f32x4 v = xr[64 * j], gg = gr[64 * j]; s += (v.x * v.x + v.y * v.y) + (v.z * v.z + v.w * v.w);
        uint2 o; o.x = pk2(v.x * gg.x, v.y * gg.y); o.y = pk2(v.z * gg.z, v.w * gg.w); *((uint2*)(XB + (size_t)row * DM) + lane + 64 * j) = o; }
    for (int o = 1; o < 64; o <<= 1) s += __shfl_xor(s, o);
    if (lane < 4) *((f32x4*)(SSQ + (size_t)row * NSSQ) + lane) = (f32x4){lane == 0 ? s : 0.f, 0.f, 0.f, 0.f};
}
enum { EPI_PROJ = 0, EPI_RES = 1, EPI_SWIGLU = 2 };
struct EpiArgs { bf16* outb; float* outf; const float* base; const float* SSQ; int ldc; int pad; };
template <int EPI, int NB> __global__ void __launch_bounds__(256) k_gemm(const bf16* __restrict__ A, const bf16* __restrict__ Bt, int K, EpiArgs e) {
    const int lane = threadIdx.x & 63, w = threadIdx.x >> 6, fr = lane & 15, fq = lane >> 4;
    const int m0 = blockIdx.y * 128 + 64 * (w >> 1), n0 = blockIdx.x * (NB * 128) + 64 * (w & 1);
    f32x4 acc[NB][4][4];
    for (int g = 0; g < NB; ++g) for (int i = 0; i < 4; ++i) for (int j = 0; j < 4; ++j) acc[g][i][j] = (f32x4){0.f, 0.f, 0.f, 0.f};
    const bf16* ap = A + (size_t)(m0 + fr) * K + 8 * fq; const bf16* bp = Bt + (size_t)(n0 + fr) * K + 8 * fq;
    for (int k0 = 0; k0 < K; k0 += 32) {
        bf16x8 af[4], bfr[NB][4];
#pragma unroll
        for (int i = 0; i < 4; ++i) af[i] = *(const bf16x8*)(ap + (size_t)(16 * i) * K + k0);
#pragma unroll
        for (int g = 0; g < NB; ++g)
#pragma unroll
            for (int j = 0; j < 4; ++j) bfr[g][j] = *(const bf16x8*)(bp + (size_t)(128 * g + 16 * j) * K + k0);
#pragma unroll
        for (int g = 0; g < NB; ++g)
#pragma unroll
            for (int i = 0; i < 4; ++i)
#pragma unroll
                for (int j = 0; j < 4; ++j) acc[g][i][j] = __builtin_amdgcn_mfma_f32_16x16x32_bf16(bfr[g][j], af[i], acc[g][i][j], 0, 0, 0);
    }
#pragma unroll
    for (int i = 0; i < 4; ++i) {
        const int row = m0 + 16 * i + fr;
        if (EPI == EPI_PROJ) {
            const float r = pg8::rstd16(e.SSQ, row);
#pragma unroll
            for (int j = 0; j < 4; ++j) { const int col = n0 + 16 * j + 4 * fq; const float s = (col < ATTW) ? r * C2 : r; const f32x4 v = acc[0][i][j] * s;
                uint2 o; o.x = pk2(v.x, v.y); o.y = pk2(v.z, v.w); *(uint2*)(e.outb + (size_t)row * e.ldc + col) = o; }
        } else if (EPI == EPI_RES) {
#pragma unroll
            for (int j = 0; j < 4; ++j) { const int col = n0 + 16 * j + 4 * fq; const f32x4 b = *(const f32x4*)(e.base + (size_t)row * e.ldc + col);
                *(f32x4*)(e.outf + (size_t)row * e.ldc + col) = b + acc[0][i][j]; }
        } else {
            const float r = pg8::rstd16(e.SSQ, row);
#pragma unroll
            for (int j = 0; j < 4; ++j) { const int col = blockIdx.x * 128 + 64 * (w & 1) + 16 * j + 4 * fq;
                const f32x4 gt = acc[0][i][j] * r, up = acc[NB - 1][i][j] * r; f32x4 h;
                for (int q = 0; q < 4; ++q) h[q] = gt[q] / (1.0f + __expf(-gt[q])) * up[q];
                uint2 o; o.x = pk2(h.x, h.y); o.y = pk2(h.z, h.w); *(uint2*)(e.outb + (size_t)row * e.ldc + col) = o; }
        }
    }
}
__global__ void __launch_bounds__(128) k_attn_naive(const bf16* __restrict__ PROJ, bf16* __restrict__ MIX, const float* __restrict__ lamp, int layer, const float* __restrict__ subln_g, float one_minus_lam0) {
    __shared__ float s1[SEQ], s2[SEQ], qv[128], red[8];
    const int tid = threadIdx.x, qpos = blockIdx.x, h = blockIdx.y, b = blockIdx.z;
    const size_t row = (size_t)b * SEQ + qpos;
    qv[tid] = bf2f(PROJ[row * INW + h * 128 + tid]);
    __syncthreads();
    float m1 = -INFINITY, m2 = -INFINITY;
    for (int j = tid; j <= qpos; j += 128) {
        const bf16* kr = PROJ + ((size_t)b * SEQ + j) * INW + ATTW + h * 128; float a1 = 0.f, a2 = 0.f;
        for (int d = 0; d < 64; ++d) { a1 += qv[d] * bf2f(kr[d]); a2 += qv[64 + d] * bf2f(kr[64 + d]); }
        s1[j] = a1; s2[j] = a2; m1 = fmaxf(m1, a1); m2 = fmaxf(m2, a2);
    }
    for (int o = 1; o < 64; o <<= 1) { m1 = fmaxf(m1, __shfl_xor(m1, o)); m2 = fmaxf(m2, __shfl_xor(m2, o)); }
    if ((tid & 63) == 0) { red[tid >> 6] = m1; red[2 + (tid >> 6)] = m2; }
    __syncthreads();
    m1 = fmaxf(red[0], red[1]); m2 = fmaxf(red[2], red[3]);
    float l1 = 0.f, l2 = 0.f;
    for (int j = tid; j <= qpos; j += 128) { const float p1 = exp2f(s1[j] - m1), p2 = exp2f(s2[j] - m2); s1[j] = p1; s2[j] = p2; l1 += p1; l2 += p2; }
    for (int o = 1; o < 64; o <<= 1) { l1 += __shfl_xor(l1, o); l2 += __shfl_xor(l2, o); }
    if ((tid & 63) == 0) { red[4 + (tid >> 6)] = l1; red[6 + (tid >> 6)] = l2; }
    __syncthreads();
    l1 = red[4] + red[5]; l2 = red[6] + red[7];
    float o1 = 0.f, o2 = 0.f;
    const bf16* vp = PROJ + (size_t)b * SEQ * INW + 2 * ATTW + h * 128 + tid;
    for (int j = 0; j <= qpos; ++j) { const float v = bf2f(vp[(size_t)j * INW]); o1 = fmaf(s1[j], v, o1); o2 = fmaf(s2[j], v, o2); }
    const float lam = lamp[layer];
    const float a = o1 / l1 - lam * (o2 / l2);
    float ss = a * a;
    for (int o = 1; o < 64; o <<= 1) ss += __shfl_xor(ss, o);
    __syncthreads();
    if ((tid & 63) == 0) red[tid >> 6] = ss;
    __syncthreads();
    ss = red[0] + red[1];
    const float y = a * (1.0f / sqrtf(ss * (1.0f / DV) + EPS)) * subln_g[tid] * one_minus_lam0;
    MIX[row * DM + h * 128 + tid] = (bf16)f2bf(y);
}
__global__ void __launch_bounds__(256) k_pool_naive(const bf16* __restrict__ PROJ, bf16* __restrict__ MIX) {
    const int idx = blockIdx.x * 256 + threadIdx.x, c = idx & 511, row = idx >> 9, t = row & (SEQ - 1), g = c >> 7, w = 2 << g;
    const int n = (t + 1 < w) ? (t + 1) : w;
    const bf16* up = PROJ + (size_t)row * INW + 3 * ATTW + c; float s = 0.f;
    for (int i = 0; i < n; ++i) s += bf2f(*(up - (size_t)i * INW));
    MIX[(size_t)row * DM + ATTW + c] = (bf16)f2bf(s / (float)n - bf2f(*up));
}
__global__ void __launch_bounds__(256) k_final(float* __restrict__ x, const float* __restrict__ g) {
    const int row = blockIdx.x * 4 + (threadIdx.x >> 6), lane = threadIdx.x & 63;
    f32x4* xr = (f32x4*)(x + (size_t)row * DM) + lane; const f32x4* gr = (const f32x4*)g + lane;
    f32x4 v[4]; float s = 0.f;
    for (int j = 0; j < 4; ++j) { v[j] = xr[64 * j]; s += (v[j].x * v[j].x + v[j].y * v[j].y) + (v[j].z * v[j].z + v[j].w * v[j].w); }
    for (int o = 1; o < 64; o <<= 1) s += __shfl_xor(s, o);
    const float r = 1.0f / sqrtf(s * (1.0f / DM) + EPS);
    for (int j = 0; j < 4; ++j) xr[64 * j] = v[j] * r * gr[64 * j];
}
static void naive_phase(int p, const Ptrs& P, unsigned char* ws, hipStream_t stream) {
    float* LAM = (float*)(ws + WS_LAM);
    if (p == 0) {
        for (int l = 0; l < DEPTH; ++l) {
            k_transpose<<<512, 256, 0, stream>>>(P.w_in + (size_t)l * DM * INW, DM, INW, P.W1 + (size_t)l * INW * DM, DM, 0, 0);
            k_transpose<<<512, 256, 0, stream>>>(P.w_out + (size_t)l * DM * DM, ATTW, DM, P.WO + (size_t)l * DM * DM, DM, 0, 0);
            k_transpose<<<512, 256, 0, stream>>>(P.w_gate + (size_t)l * DM * DFF, DM, DFF, P.WGU + (size_t)l * NGU * DM, DM, 0, 1);
            k_transpose<<<512, 256, 0, stream>>>(P.w_up + (size_t)l * DM * DFF, DM, DFF, P.WGU + (size_t)l * NGU * DM, DM, 128, 1);
            k_transpose<<<512, 256, 0, stream>>>(P.w_down + (size_t)l * DFF * DM, DFF, DM, P.WD + (size_t)l * DM * DFF, DFF, 0, 0);
            k_fold_pool<<<512 * 1024 / 256, 256, 0, stream>>>(P.pool_w + (size_t)l * 4 * 128 * 128, P.pool_scale + l * 512, P.w_out + (size_t)l * DM * DM, P.WO + (size_t)l * DM * DM);
        }
        k_prep_x<<<M / 4, 256, 0, stream>>>(P.x, P.norm1_g, P.XB, P.SSQ);
        return;
    }
    if (p == NPHASE - 1) { k_final<<<M / 4, 256, 0, stream>>>(P.out, P.final_g); return; }
    const int l = (p - 1) / 5, k = (p - 1) % 5;
    if (k == 0) { EpiArgs e{P.PROJ, nullptr, nullptr, P.SSQ, INW, 0}; k_gemm<EPI_PROJ, 1><<<dim3(INW / 128, M / 128), 256, 0, stream>>>(P.XB, P.W1 + (size_t)l * INW * DM, DM, e); }
    if (k == 1) { k_lambda<<<1, 64, 0, stream>>>(P.lam_qk, LAM);
        k_attn_naive<<<dim3(SEQ, NH, BATCH), 128, 0, stream>>>(P.PROJ, P.MIX, LAM, l, P.subln_g + l * DV, 1.0f - (l == 0 ? LAM0_0 : LAM0_1));
        k_pool_naive<<<M * 512 / 256, 256, 0, stream>>>(P.PROJ, P.MIX); }
    if (k == 2) { EpiArgs e{nullptr, P.out, l == 0 ? P.x : P.out, nullptr, DM, 0}; k_gemm<EPI_RES, 1><<<dim3(DM / 128, M / 128), 256, 0, stream>>>(P.MIX, P.WO + (size_t)l * DM * DM, DM, e);
        k_prep_x<<<M / 4, 256, 0, stream>>>(P.out, P.norm2_g + l * DM, P.XB, P.SSQ); }
    if (k == 3) { EpiArgs e{P.H, nullptr, nullptr, P.SSQ, DFF, 0}; k_gemm<EPI_SWIGLU, 2><<<dim3(DFF / 128, M / 128), 256, 0, stream>>>(P.XB, P.WGU + (size_t)l * NGU * DM, DM, e); }
    if (k == 4) { EpiArgs e{nullptr, P.out, P.out, nullptr, DM, 0}; k_gemm<EPI_RES, 1><<<dim3(DM / 128, M / 128), 256, 0, stream>>>(P.H, P.WD + (size_t)l * DM * DFF, DFF, e);
        if (l + 1 < DEPTH) k_prep_x<<<M / 4, 256, 0, stream>>>(P.out, P.norm1_g + (l + 1) * DM, P.XB, P.SSQ); }
}
#endif

extern "C" void kernel_launch(void* const* d_in, const int* in_sizes, int n_in, void* d_out, int out_size, void* d_ws, size_t ws_size, hipStream_t stream) {
    static int grid = 0;
    if (grid == 0) {
        if (n_in != 13 || in_sizes[0] != M * DM || out_size != M * DM || ws_size < WS_END) { fprintf(stderr, "kernel_launch: unexpected shapes (n_in %d, ws %zu); nothing launched\n", n_in, ws_size); grid = -1; return; }
        int dev = 0, cus = 0, per_cu = 0;
        if (hipGetDevice(&dev) != hipSuccess || hipDeviceGetAttribute(&cus, hipDeviceAttributeMultiprocessorCount, dev) != hipSuccess) { fprintf(stderr, "kernel_launch: device query failed\n"); grid = -1; return; }
        if (hipFuncSetAttribute((const void*)mk_fwd, hipFuncAttributeMaxDynamicSharedMemorySize, LDS_BYTES) != hipSuccess) { fprintf(stderr, "kernel_launch: hipFuncSetAttribute failed\n"); grid = -1; return; }
        if (hipOccupancyMaxActiveBlocksPerMultiprocessor(&per_cu, (const void*)mk_fwd, NWAVES * 64, LDS_BYTES) != hipSuccess || per_cu < 1)
            fprintf(stderr, "kernel_launch: note: occupancy query reports %d workgroups per CU\n", per_cu);
        (void)hipGetLastError();
        grid = cus;
    }
    if (grid < 0) return;
    if (hipMemsetAsync((char*)d_ws + WS_CTL, 0, CTL_ZERO_BYTES, stream) != hipSuccess) { fprintf(stderr, "kernel_launch: hipMemsetAsync failed\n"); return; }
    Args a{};
    for (int i = 0; i < 13; ++i) a.in[i] = (const float*)d_in[i];
    a.out = (float*)d_out; a.ws = (unsigned char*)d_ws;
#if MK_ONE_LAUNCH
    a.ph_lo = 0; a.ph_hi = NPHASE;
    hipLaunchKernelGGL(mk_fwd, dim3(grid), dim3(NWAVES * 64), LDS_BYTES, stream, a);
#else
    unsigned char* ws = (unsigned char*)d_ws;
    Ptrs P;
    P.x = a.in[0]; P.norm1_g = a.in[1]; P.w_in = a.in[2]; P.lam_qk = a.in[3]; P.subln_g = a.in[4]; P.pool_w = a.in[5]; P.pool_scale = a.in[6]; P.w_out = a.in[7];
    P.norm2_g = a.in[8]; P.w_gate = a.in[9]; P.w_up = a.in[10]; P.w_down = a.in[11]; P.final_g = a.in[12]; P.out = a.out;
    P.W1 = (bf16*)(ws + WS_W1); P.WO = (bf16*)(ws + WS_WO); P.WGU = (bf16*)(ws + WS_WGU); P.WD = (bf16*)(ws + WS_WD); P.XB = (bf16*)(ws + WS_XB);
    P.PROJ = (bf16*)(ws + WS_PROJ); P.MIX = (bf16*)(ws + WS_MIX); P.H = (bf16*)(ws + WS_H); P.SSQ = (float*)(ws + WS_SSQ);
    for (int p = 0; p < NPHASE; ++p) {
        if ((MK_NAIVE_MASK >> p) & 1u) { naive_phase(p, P, ws, stream); continue; }
        a.ph_lo = p; a.ph_hi = p + 1;
        hipLaunchKernelGGL(mk_fwd, dim3(grid), dim3(NWAVES * 64), LDS_BYTES, stream, a);
#ifdef MK_DUP_MASK
        if ((MK_DUP_MASK >> p) & 1u) hipLaunchKernelGGL(mk_fwd, dim3(grid), dim3(NWAVES * 64), LDS_BYTES, stream, a);
#endif
    }
#endif
    const hipError_t le = hipPeekAtLastError();
    if (le != hipSuccess) fprintf(stderr, "kernel_launch: launch failed: %s (grid %d)\n", hipGetErrorName(le), grid);
}
```

```cpp
#include <hip/hip_runtime.h>
#include <cstdio>
#include <cstdint>
#include <cmath>

constexpr int BATCH = 8, SEQ = 2048, DM = 1024, DEPTH = 2, M = BATCH * SEQ;
constexpr int NH = 4, DV = 128, ATTW = 512, INW = 2048, DFF = 2816, NGU = 2 * DFF;
constexpr float EPS = 1e-5f;
constexpr float C2 = 0.125f * 1.4426950408889634f;
constexpr float LAM0_0 = 0.2f, LAM0_1 = 0.35550906759096926f;
constexpr int NSSQ = 16;

#define MK_ONE_LAUNCH 1
#define MK_NAIVE_MASK 0u
namespace pg8 {
#define PG8_LAS __attribute__((address_space(3)))
typedef unsigned short bf16_t;
typedef short bf16x8 __attribute__((ext_vector_type(8)));
typedef float f32x4 __attribute__((ext_vector_type(4)));
typedef unsigned u32x4 __attribute__((ext_vector_type(4)));
constexpr int BM = 256, BK = 64, HALF = 128, HTB = HALF * BK * 2  , STAGE_BYTES = 8 * HTB, NXCD = 8, WGM = 8;

__host__ __device__ __forceinline__ int lds_byte(int r, int c) { const int st = (r >> 4) * 2 + (c >> 5), rr = r & 15, cc = c & 31, ob = rr * 64 + cc * 2; return st * 1024 + (ob ^ (((ob >> 9) & 1) << 5)); }
__host__ __device__ __forceinline__ void stage_rc(int b, int& R, int& C) { const int st = b / 1024, sb = b % 1024, swz = sb ^ (((sb >> 9) & 1) << 5); R = (st >> 1) * 16 + swz / 64; C = (st & 1) * 32 + (swz % 64) / 2; }
__host__ __device__ __forceinline__ int perm32(int rho) { const int n = rho >> 4, i = rho & 15; return 8 * (i >> 2) + 4 * n + (i & 3); }

struct Unit { int pm, pn; };
struct Gemm { const bf16_t* A; const bf16_t* Bt; int M, N, K; };

struct StaticOrder {
    int nM, nN, nwg, G, c;
    __host__ __device__ void init(int M, int N, int G_, int c_) { nM = M / BM; nN = N / BM; nwg = nM * nN; G = G_; c = c_; }
    __host__ __device__ bool next(int i, Unit& u) const {
        const long L = (long)i * G + c; if (L >= nwg) return false;
        int wgid = (int)L; { const int q = nwg / NXCD, r = nwg % NXCD, xcd = wgid % NXCD, off = wgid / NXCD; wgid = (xcd < r ? xcd * (q + 1) : r * (q + 1) + (xcd - r) * q) + off; }
        const int nig = WGM * nN, gid = wgid / nig, fm = gid * WGM, gsz = (nM - fm) < WGM ? (nM - fm) : WGM;
        u.pm = fm + ((wgid % nig) % gsz); u.pn = (wgid % nig) / gsz; return true;
    }
    __device__ __forceinline__ void a_ready(const Unit&) const {}
    __device__ __forceinline__ void done(const Unit&) const {}
};

__device__ __forceinline__ unsigned cvt_pk_bf16(float lo, float hi) { unsigned r; asm volatile("v_cvt_pk_bf16_f32 %0, %1, %2" : "=v"(r) : "v"(lo), "v"(hi)); return r; }
__device__ __forceinline__ float rstd16(const float* SSQ, int row) {
    const f32x4* p = (const f32x4*)(SSQ + (size_t)row * NSSQ); const f32x4 a = p[0], b = p[1], c = p[2], d = p[3];
    const float s = ((a[0] + a[1]) + (a[2] + a[3])) + ((b[0] + b[1]) + (b[2] + b[3])) + ((c[0] + c[1]) + (c[2] + c[3])) + ((d[0] + d[1]) + (d[2] + d[3]));
    return 1.0f / sqrtf(s * (1.0f / DM) + EPS);
}
struct EpiProj {
    static constexpr bool PERM = true, AFTER_DRAIN = false;
    bf16_t* O; const float* SSQ;
    __device__ __forceinline__ void operator()(const f32x4 (&acc)[2][2][4][2], const Unit& u, int wr, int wc, int fr, int fq) const {
        const int row0 = u.pm * BM + wr * 64 + fr, col0 = u.pn * BM + wc * 32 + 8 * fq;
        const float qs = (u.pn < 2) ? C2 : 1.0f;
#pragma unroll
        for (int ai = 0; ai < 2; ++ai)
#pragma unroll
            for (int m = 0; m < 4; ++m) { const int row = row0 + ai * HALF + m * 16; const float r = rstd16(SSQ, row) * qs; bf16_t* rowp = O + (size_t)row * INW + col0;
#pragma unroll
                for (int bj = 0; bj < 2; ++bj) { const f32x4 v0 = acc[ai][bj][m][0] * r, v1 = acc[ai][bj][m][1] * r;
                    u32x4 w; w.x = cvt_pk_bf16(v0[0], v0[1]); w.y = cvt_pk_bf16(v0[2], v0[3]); w.z = cvt_pk_bf16(v1[0], v1[1]); w.w = cvt_pk_bf16(v1[2], v1[3]);
                    *(u32x4*)(rowp + bj * HALF) = w; } }
    }
};
struct EpiSwiglu {
    static constexpr bool PERM = true, AFTER_DRAIN = false;
    bf16_t* O; const float* SSQ;
    __device__ __forceinline__ void operator()(const f32x4 (&acc)[2][2][4][2], const Unit& u, int wr, int wc, int fr, int fq) const {
        const int row0 = u.pm * BM + wr * 64 + fr, col0 = u.pn * HALF + wc * 32 + 8 * fq;
#pragma unroll
        for (int ai = 0; ai < 2; ++ai)
#pragma unroll
            for (int m = 0; m < 4; ++m) { const int row = row0 + ai * HALF + m * 16; const float r = rstd16(SSQ, row); float hv[8];
#pragma unroll
                for (int n = 0; n < 2; ++n)
#pragma unroll
                    for (int q = 0; q < 4; ++q) { const float g = acc[ai][0][m][n][q] * r, up = acc[ai][1][m][n][q] * r;
                        hv[4 * n + q] = g * __builtin_amdgcn_rcpf(1.0f + __builtin_amdgcn_exp2f(-1.4426950408889634f * g)) * up; }
                u32x4 w; w.x = cvt_pk_bf16(hv[0], hv[1]); w.y = cvt_pk_bf16(hv[2], hv[3]); w.z = cvt_pk_bf16(hv[4], hv[5]); w.w = cvt_pk_bf16(hv[6], hv[7]);
                *(u32x4*)(O + (size_t)row * DFF + col0) = w; }
    }
};
struct EpiRes {
    static constexpr bool PERM = true, AFTER_DRAIN = false;
    const float* basef; bf16_t* XS; float* outf; float* SSQ;
    __device__ __forceinline__ void operator()(const f32x4 (&acc)[2][2][4][2], const Unit& u, int wr, int wc, int fr, int fq) const {
        const int row0 = u.pm * BM + wr * 64 + fr, col0 = u.pn * BM + wc * 32 + 8 * fq;
#pragma unroll
        for (int ai = 0; ai < 2; ++ai)
#pragma unroll
            for (int m = 0; m < 4; ++m) { const int row = row0 + ai * HALF + m * 16; const size_t off = (size_t)row * DM + col0; float ss = 0.f;
#pragma unroll
                for (int bj = 0; bj < 2; ++bj) { f32x4 x0, x1;
                    if (basef) { x0 = *(const f32x4*)(basef + off + bj * HALF); x1 = *(const f32x4*)(basef + off + bj * HALF + 4); }
                    else { const u32x4 b = *(const u32x4*)(XS + off + bj * HALF);
                        x0 = (f32x4){__uint_as_float(b.x << 16), __uint_as_float(b.x & 0xffff0000u), __uint_as_float(b.y << 16), __uint_as_float(b.y & 0xffff0000u)};
                        x1 = (f32x4){__uint_as_float(b.z << 16), __uint_as_float(b.z & 0xffff0000u), __uint_as_float(b.w << 16), __uint_as_float(b.w & 0xffff0000u)}; }
                    x0 += acc[ai][bj][m][0]; x1 += acc[ai][bj][m][1];
                    ss += ((x0[0] * x0[0] + x0[1] * x0[1]) + (x0[2] * x0[2] + x0[3] * x0[3])) + ((x1[0] * x1[0] + x1[1] * x1[1]) + (x1[2] * x1[2] + x1[3] * x1[3]));
                    if (outf) { *(f32x4*)(outf + off + bj * HALF) = x0; *(f32x4*)(outf + off + bj * HALF + 4) = x1; }
                    else { u32x4 w; w.x = cvt_pk_bf16(x0[0], x0[1]); w.y = cvt_pk_bf16(x0[2], x0[3]); w.z = cvt_pk_bf16(x1[0], x1[1]); w.w = cvt_pk_bf16(x1[2], x1[3]);
                        *(u32x4*)(XS + off + bj * HALF) = w; } }
                ss += __shfl_xor(ss, 16); ss += __shfl_xor(ss, 32);
                if (fq == 0) SSQ[(size_t)row * NSSQ + 4 * u.pn + wc] = ss;
                if (m & 1) asm volatile("" ::: "memory"); }
    }
};

template <class Epi, class Sched, bool ALIGN_EPI = false, bool SP2 = false>
__device__ __forceinline__ void gemm_phase(PG8_LAS unsigned char* lds, const Gemm g, const Sched& S, const Epi& E) {
    int tid_o = threadIdx.x; asm volatile("" : "+v"(tid_o));
    const int tid = tid_o, wid = __builtin_amdgcn_readfirstlane(tid >> 6), lane = tid & 63, wr = wid >> 2, wc = wid & 3, fr = lane & 15, fq = lane >> 4;
    const int K = g.K, nt = K / BK;
    unsigned voffA[2], voffB[2];
#pragma unroll
    for (int i = 0; i < 2; ++i) { int R, C; stage_rc(tid * 16 + i * 8192, R, C); const int Rb = Epi::PERM ? ((R & ~31) + perm32(R & 31)) : R;
        voffA[i] = (unsigned)(R * K + C) * 2u; voffB[i] = (unsigned)(Rb * K + C) * 2u; }
    const size_t kstep = (size_t)(BK * 2);
    const size_t hstep = (size_t)HALF * K * 2;
    const size_t tstep = 2 * hstep;
    const unsigned ldsw = (unsigned)wid * 1024u;
    const int aoff = lds_byte(wr * 64 + fr, fq * 8), boff = lds_byte(wc * 32 + fr, fq * 8);
#define PG8_SA(b, h) (((b) * 2 + (h)) * HTB)
#define PG8_SB(b, h) ((4 + (b) * 2 + (h)) * HTB)
#define PG8_STAGE(bufoff, gbase, voff) do { _Pragma("unroll") for (int _i = 0; _i < 2; ++_i) \
        __builtin_amdgcn_global_load_lds((const unsigned*)((const char*)(gbase) + (voff)[_i]), (PG8_LAS unsigned*)(lds + (bufoff) + ldsw + _i * 8192), 16, 0, 0); } while (0)
#define PG8_LDA(dst, b, h) do { _Pragma("unroll") for (int m = 0; m < 4; ++m) _Pragma("unroll") for (int k = 0; k < 2; ++k) dst[m][k] = *(const PG8_LAS bf16x8*)(lds + PG8_SA(b, h) + aoff + m * 2048 + k * 1024); } while (0)
#define PG8_LDB(dst, b, h) do { _Pragma("unroll") for (int n = 0; n < 2; ++n) _Pragma("unroll") for (int k = 0; k < 2; ++k) dst[n][k] = *(const PG8_LAS bf16x8*)(lds + PG8_SB(b, h) + boff + n * 2048 + k * 1024); } while (0)
#define PG8_MMA(ai, bj, At, Bt) do { __builtin_amdgcn_s_setprio(1); _Pragma("unroll") for (int m = 0; m < 4; ++m) _Pragma("unroll") for (int n = 0; n < 2; ++n) _Pragma("unroll") for (int k = 0; k < 2; ++k) \
        acc[ai][bj][m][n] = __builtin_amdgcn_mfma_f32_16x16x32_bf16(Bt[n][k], At[m][k], acc[ai][bj][m][n], 0, 0, 0); __builtin_amdgcn_s_setprio(0); } while (0)
#define PG8_WAIT_V(n) asm volatile("s_waitcnt vmcnt(" #n ")" ::: "memory")
#define PG8_WAIT_L(n) asm volatile("s_waitcnt lgkmcnt(" #n ")" ::: "memory")
#define PG8_BAR __builtin_amdgcn_s_barrier()
#define PG8_SCHED __builtin_amdgcn_sched_barrier(0)
    Unit cur, nxt; int ui = 0;
    if (!S.next(0, cur)) return;
    f32x4 acc[2][2][4][2];
#pragma unroll
    for (int a = 0; a < 2; ++a)
#pragma unroll
        for (int b = 0; b < 2; ++b)
#pragma unroll
            for (int m = 0; m < 4; ++m)
#pragma unroll
                for (int n = 0; n < 2; ++n) acc[a][b][m][n] = (f32x4){0.f, 0.f, 0.f, 0.f};
    bf16x8 At[4][2], B0[2][2], B1[2][2];
    const char* cA = (const char*)g.A + (size_t)cur.pm * tstep; const char* cB = (const char*)g.Bt + (size_t)cur.pn * tstep;
    S.a_ready(cur);
    if constexpr (SP2) {
        PG8_STAGE(PG8_SB(0, 0), cB, voffB); PG8_STAGE(PG8_SB(0, 1), cB + hstep, voffB); PG8_STAGE(PG8_SA(0, 0), cA, voffA); PG8_STAGE(PG8_SA(0, 1), cA + hstep, voffA);
        if (wr == 1) PG8_BAR;
        PG8_WAIT_V(2); PG8_BAR;
        PG8_STAGE(PG8_SB(1, 0), cB + kstep, voffB); PG8_STAGE(PG8_SA(1, 0), cA + kstep, voffA); PG8_STAGE(PG8_SB(1, 1), cB + hstep + kstep, voffB);
        PG8_WAIT_V(6); PG8_BAR;
    } else {
        PG8_STAGE(PG8_SB(0, 0), cB, voffB); PG8_STAGE(PG8_SA(0, 0), cA, voffA); PG8_STAGE(PG8_SB(0, 1), cB + hstep, voffB); PG8_STAGE(PG8_SA(0, 1), cA + hstep, voffA);
        if (wr == 1) PG8_BAR;
        PG8_WAIT_V(4); PG8_BAR;
        PG8_STAGE(PG8_SB(1, 0), cB + kstep, voffB); PG8_STAGE(PG8_SA(1, 0), cA + kstep, voffA); PG8_STAGE(PG8_SB(1, 1), cB + hstep + kstep, voffB);
        PG8_WAIT_V(6); PG8_BAR;
    }
    for (;;) {
        const bool has_next = S.next(ui + 1, nxt);
        const char* nA = has_next ? (const char*)g.A + (size_t)nxt.pm * tstep : cA; const char* nB = has_next ? (const char*)g.Bt + (size_t)nxt.pn * tstep : cB;
        for (int t = 0; t < nt; t += 2) {
            const bool last = (t == nt - 2);
            const char* a1 = cA + (size_t)(t + 1) * kstep;
            const char* a2 = last ? nA : cA + (size_t)(t + 2) * kstep; const char* b2 = last ? nB : cB + (size_t)(t + 2) * kstep;
            const char* a3 = a2 + kstep; const char* b3 = b2 + kstep;
            if (last && has_next) S.a_ready(nxt);
            if constexpr (SP2) {
            PG8_LDB(B0, 0, 0); PG8_LDB(B1, 0, 1); PG8_SCHED; PG8_LDA(At, 0, 0); PG8_STAGE(PG8_SA(1, 1), a1 + hstep, voffA);
            PG8_WAIT_V(8); PG8_WAIT_L(0); PG8_BAR; PG8_MMA(0, 0, At, B0); PG8_MMA(0, 1, At, B1); PG8_BAR; PG8_SCHED;
            PG8_LDA(At, 0, 1); PG8_STAGE(PG8_SB(0, 0), b2, voffB); PG8_STAGE(PG8_SB(0, 1), b2 + hstep, voffB); PG8_STAGE(PG8_SA(0, 0), a2, voffA);
            PG8_WAIT_V(8); PG8_WAIT_L(0); PG8_BAR; PG8_MMA(1, 0, At, B0); PG8_MMA(1, 1, At, B1); PG8_BAR; PG8_SCHED;
            PG8_LDB(B0, 1, 0); PG8_LDB(B1, 1, 1); PG8_SCHED; PG8_LDA(At, 1, 0); PG8_STAGE(PG8_SA(0, 1), a2 + hstep, voffA);
            PG8_WAIT_V(8); PG8_WAIT_L(0); PG8_BAR; PG8_MMA(0, 0, At, B0); PG8_MMA(0, 1, At, B1); PG8_BAR; PG8_SCHED;
            PG8_LDA(At, 1, 1); PG8_STAGE(PG8_SB(1, 0), b3, voffB); PG8_STAGE(PG8_SB(1, 1), b3 + hstep, voffB); PG8_STAGE(PG8_SA(1, 0), a3, voffA);
            PG8_WAIT_V(8); PG8_WAIT_L(0); PG8_BAR; PG8_MMA(1, 0, At, B0); PG8_MMA(1, 1, At, B1); PG8_BAR; PG8_SCHED;
            } else {
            PG8_LDB(B0, 0, 0); PG8_SCHED; PG8_LDA(At, 0, 0); PG8_STAGE(PG8_SA(1, 1), a1 + hstep, voffA);
            PG8_WAIT_L(8); PG8_BAR; PG8_WAIT_L(0); PG8_MMA(0, 0, At, B0); PG8_BAR; PG8_SCHED;
            PG8_LDB(B1, 0, 1); PG8_STAGE(PG8_SB(0, 0), b2, voffB);
            PG8_BAR; PG8_WAIT_L(0); PG8_MMA(0, 1, At, B1); PG8_BAR;
            PG8_LDA(At, 0, 1); PG8_STAGE(PG8_SA(0, 0), a2, voffA);
            PG8_BAR; PG8_WAIT_L(0); PG8_MMA(1, 0, At, B0); PG8_BAR; PG8_SCHED;
            PG8_STAGE(PG8_SB(0, 1), b2 + hstep, voffB);
            PG8_WAIT_V(6); PG8_BAR; PG8_MMA(1, 1, At, B1); PG8_BAR;
            PG8_LDB(B0, 1, 0); PG8_SCHED; PG8_LDA(At, 1, 0); PG8_STAGE(PG8_SA(0, 1), a2 + hstep, voffA);
            PG8_WAIT_L(8); PG8_BAR; PG8_WAIT_L(0); PG8_MMA(0, 0, At, B0); PG8_BAR; PG8_SCHED;
            PG8_LDB(B1, 1, 1); PG8_STAGE(PG8_SB(1, 0), b3, voffB);
            PG8_BAR; PG8_WAIT_L(0); PG8_MMA(0, 1, At, B1); PG8_BAR;
            PG8_LDA(At, 1, 1); PG8_STAGE(PG8_SA(1, 0), a3, voffA);
            PG8_BAR; PG8_WAIT_L(0); PG8_MMA(1, 0, At, B0); PG8_BAR; PG8_SCHED;
            PG8_STAGE(PG8_SB(1, 1), b3 + hstep, voffB);
            PG8_WAIT_V(6); PG8_BAR; PG8_MMA(1, 1, At, B1); PG8_BAR;
            }
        }
        if constexpr (ALIGN_EPI) { if (wr == 0) PG8_BAR; }
        if constexpr (!Epi::AFTER_DRAIN) { E(acc, cur, wr, wc, fr, fq); S.done(cur); }
        if (!has_next) break;
#pragma unroll
        for (int a = 0; a < 2; ++a)
#pragma unroll
            for (int b = 0; b < 2; ++b)
#pragma unroll
                for (int m = 0; m < 4; ++m)
#pragma unroll
                    for (int n = 0; n < 2; ++n) acc[a][b][m][n] = (f32x4){0.f, 0.f, 0.f, 0.f};
        cur = nxt; cA = nA; cB = nB; ++ui;
        if constexpr (ALIGN_EPI) { if (wr == 1) PG8_BAR; }
    }
    PG8_WAIT_V(0);
    if constexpr (!ALIGN_EPI) { if (wr == 0) PG8_BAR; }
    PG8_BAR;
    if constexpr (Epi::AFTER_DRAIN) { E.fused(acc, cur, wr, wc, fr, fq, lds, wid, lane); S.done(cur); }
#undef PG8_SA
#undef PG8_SB
#undef PG8_STAGE
#undef PG8_LDA
#undef PG8_LDB
#undef PG8_MMA
#undef PG8_WAIT_V
#undef PG8_WAIT_L
#undef PG8_BAR
#undef PG8_SCHED
}
}
namespace dattn {
typedef unsigned short bf16_t;
typedef short bf16x8 __attribute__((ext_vector_type(8)));
typedef short s16x4 __attribute__((ext_vector_type(4)));
typedef float f32x16 __attribute__((ext_vector_type(16)));
typedef float f32x4 __attribute__((ext_vector_type(4)));
typedef unsigned u32x4 __attribute__((ext_vector_type(4)));
typedef short v4i16_t __attribute__((ext_vector_type(4)));
#define DA_LAS __attribute__((address_space(3)))
typedef DA_LAS const char* lds_cptr;
constexpr int QB = 128, KVBLK = 64, PITCH = INW, NSLOT_K = 3, NSLOT_V = 4, SLOTB = 16384;
constexpr int LDS_K = 0, LDS_V = NSLOT_K * SLOTB, LDS_WS = (NSLOT_K + NSLOT_V) * SLOTB, LDS_BYTES = LDS_WS + 8 * 256;
constexpr int LDS_XCH = 0;
constexpr float THR = 6.0f;
__device__ __forceinline__ int crow(int r, int hi) { return (r & 3) + 8 * (r >> 2) + 4 * hi; }
__device__ __forceinline__ void dma16(unsigned voff, __amdgpu_buffer_rsrc_t srd, unsigned soff, unsigned lds_dst) { unsigned keep;
    asm volatile("s_mov_b32 %0, m0\n\ts_mov_b32 m0, %4\n\ts_nop 4\n\tbuffer_load_dwordx4 %1, %2, %3 offen lds\n\ts_mov_b32 m0, %0" : "=&s"(keep) : "v"(voff), "s"(srd), "s"(soff), "s"(lds_dst) : "memory"); }
typedef float f32x2_t __attribute__((ext_vector_type(2))); typedef __bf16 bf16x2_t __attribute__((ext_vector_type(2)));
__device__ __forceinline__ unsigned cvtpk_s(float lo, float hi) { f32x2_t v = {lo, hi}; bf16x2_t b = __builtin_convertvector(v, bf16x2_t); return __builtin_bit_cast(unsigned, b); }
__device__ __forceinline__ s16x4 vtr(lds_cptr p) { return __builtin_bit_cast(s16x4, __builtin_amdgcn_ds_read_tr16_b64_v4i16((DA_LAS v4i16_t*)p)); }
__device__ __forceinline__ float max3f(float a, float b, float c) { float r; asm("v_max3_f32 %0, %1, %2, %3" : "=v"(r) : "v"(a), "v"(b), "v"(c)); return r; }
__device__ __forceinline__ float max2f(float a, float b) { float r; asm("v_max_f32_e32 %0, %1, %2" : "=v"(r) : "v"(a), "v"(b)); return r; }
#define DA_WAIT_BAR(N) asm volatile("s_waitcnt vmcnt(" #N ") lgkmcnt(0)\n\ts_barrier" ::: "memory")
#define DA_MFMA(a, b, c) __builtin_amdgcn_mfma_f32_32x32x16_bf16(a, b, c, 0, 0, 0)

#define DA_SB() __builtin_amdgcn_sched_barrier(0)
__device__ __forceinline__ void k_frags(bf16x8 (&kf)[8], lds_cptr kp) {
#pragma unroll
    for (int d0 = 0; d0 < 4; ++d0) { kf[2 * d0] = *(const DA_LAS bf16x8*)(kp + d0 * 2048); kf[2 * d0 + 1] = *(const DA_LAS bf16x8*)(kp + d0 * 2048 + 512); }
    DA_SB();
}
__device__ __forceinline__ void qk_tile(f32x16& p0, f32x16& p1, const bf16x8 (&kf)[8], const bf16x8 (&qr)[4], const f32x16& negm) {
    p0 = DA_MFMA(kf[0], qr[0], negm); p1 = DA_MFMA(kf[1], qr[0], negm);
#pragma unroll
    for (int d0 = 1; d0 < 4; ++d0) { p0 = DA_MFMA(kf[2 * d0], qr[d0], p0); p1 = DA_MFMA(kf[2 * d0 + 1], qr[d0], p1); }
    asm volatile("s_nop 15\n\ts_nop 7" : "+v"(p0), "+v"(p1));
    DA_SB();
}
__device__ __forceinline__ void pv_tile(f32x16 (&o)[4], lds_cptr vp, const u32x4 (&pw)[4]) {
    s16x4 lo[4], hv[4];
#define DA_VRD(i) do { lo[(i) & 3] = vtr(vp + ((i) >> 2) * 4096 + ((i) & 3) * 1024); hv[(i) & 3] = vtr(vp + ((i) >> 2) * 4096 + ((i) & 3) * 1024 + 512); } while (0)
    DA_VRD(0); DA_VRD(1); DA_VRD(2); DA_SB();
#pragma unroll
    for (int i = 0; i < 16; ++i) {
        if (i + 3 < 16) { DA_VRD(i + 3); }
        DA_SB();
        const bf16x8 vf = (bf16x8){lo[i & 3][0], lo[i & 3][1], lo[i & 3][2], lo[i & 3][3], hv[i & 3][0], hv[i & 3][1], hv[i & 3][2], hv[i & 3][3]};
        o[i >> 2] = DA_MFMA(__builtin_bit_cast(bf16x8, pw[i & 3]), vf, o[i >> 2]);
        DA_SB();
    }
#undef DA_VRD
}
template <bool MASK> __device__ __forceinline__ void softmax_tile(f32x16& p0, f32x16& p1, u32x4 (&pw)[4], f32x16 (&o)[4], f32x16& negm, float& m, float& l, bool first, int kb, int qrel, int hi, int r32, DA_LAS float* wsf) {
    if (MASK) {
#pragma unroll
        for (int r = 0; r < 16; ++r) { const int kv = kb + (r & 3) + 8 * (r >> 2); if (kv > qrel) p0[r] = -INFINITY; if (kv + 32 > qrel) p1[r] = -INFINITY; } }
    float a = max3f(p0[0], p0[1], p1[0]), b = max3f(p0[2], p0[3], p1[1]); a = max3f(a, p1[2], p1[3]);
#pragma unroll
    for (int r = 4; r < 16; r += 4) { a = max3f(a, p0[r], p0[r + 1]); b = max3f(b, p0[r + 2], p0[r + 3]); a = max3f(a, p1[r], p1[r + 1]); b = max3f(b, p1[r + 2], p1[r + 3]); }
    float rm = max2f(a, b);
    { auto rr = __builtin_amdgcn_permlane32_swap(__float_as_uint(rm), __float_as_uint(rm), false, false); rm = max2f(__uint_as_float(rr[0]), __uint_as_float(rr[1])); }
    if (first || __any(rm > THR)) {
        const float dl = first ? rm : fmaxf(rm, 0.f); m += dl;
#pragma unroll
        for (int r = 0; r < 16; ++r) { p0[r] -= dl; p1[r] -= dl; }
#pragma unroll
        for (int r = 0; r < 16; ++r) negm[r] = -m;
        if (!first) { const float f = __builtin_amdgcn_exp2f(-dl); l *= f;
            if (hi == 0) wsf[r32] = f;
#pragma unroll
            for (int r = 0; r < 16; ++r) { const float fr_ = wsf[crow(r, hi)];
#pragma unroll
                for (int db = 0; db < 4; ++db) o[db][r] *= fr_; } }
    }
    float sacc = 0.f;
#pragma unroll
    for (int r = 0; r < 16; ++r) { p0[r] = __builtin_amdgcn_exp2f(p0[r]); p1[r] = __builtin_amdgcn_exp2f(p1[r]); sacc += p0[r] + p1[r]; }
    l += sacc;
#pragma unroll
    for (int i = 0; i < 4; ++i) { pw[0][i] = cvtpk_s(p0[2 * i], p0[2 * i + 1]); pw[1][i] = cvtpk_s(p0[8 + 2 * i], p0[9 + 2 * i]); pw[2][i] = cvtpk_s(p1[2 * i], p1[2 * i + 1]); pw[3][i] = cvtpk_s(p1[8 + 2 * i], p1[9 + 2 * i]); }
}

__device__ __forceinline__ void attn_unit(int b, int h, int qb, const bf16_t* PROJ, bf16_t* MIX, float lam, const float* sg, float oml0, char* shm) {
    int tid_o = threadIdx.x; asm volatile("" : "+v"(tid_o));
    const int tid = tid_o, lane = tid & 63, r32 = lane & 31, hi = lane >> 5;
    const int wid = __builtin_amdgcn_readfirstlane(tid >> 6), c = wid >> 2, wq = wid & 3;
    const long rowbase = (long)b * SEQ; const int q0 = qb * QB;
    const bf16_t* Qw = PROJ + (rowbase + q0 + wq * 32) * PITCH + h * 128 + c * 64;
    const unsigned lds0 = (unsigned)(uintptr_t)shm;
    const lds_cptr shm3 = (lds_cptr)shm;
    DA_LAS float* wsf = (DA_LAS float*)(shm3 + LDS_WS) + wid * 64;
    const __amdgpu_buffer_rsrc_t srd = __builtin_amdgcn_make_buffer_rsrc((void*)(PROJ + rowbase * PITCH), (short)0, SEQ * PITCH * 2, 0x00020000);
    const unsigned kvoff = (unsigned)(lane * PITCH + ATTW + h * 128 + wid * 8) * 2u;
    const unsigned vvoff = (unsigned)((16 * (wid & 3) + (lane >> 2)) * PITCH + 2 * ATTW + h * 128 + (wid >> 2) * 32 + (lane & 3) * 8) * 2u;
    const unsigned kdst = lds0 + LDS_K + wid * 1024, vdst = lds0 + LDS_V + wid * 1024;
#define DA_RFL(x) ((unsigned)__builtin_amdgcn_readfirstlane((int)(x)))
#define DA_DMA_TILE(t, kslot, vslot) do { const unsigned so_ = DA_RFL((unsigned)(t) * (unsigned)(KVBLK * PITCH * 2)); \
        dma16(kvoff, srd, so_, DA_RFL(kdst + (kslot))); dma16(kvoff, srd, so_ + 128u, DA_RFL(kdst + (kslot) + 8192)); \
        dma16(vvoff, srd, so_, DA_RFL(vdst + (vslot))); dma16(vvoff, srd, so_ + 128u, DA_RFL(vdst + (vslot) + 8192)); } while (0)
    const int NT = 2 * (qb + 1);
    DA_DMA_TILE(0, 0, 0); DA_DMA_TILE(1, SLOTB, SLOTB);
    bf16x8 qr[4];
#pragma unroll
    for (int d0 = 0; d0 < 4; ++d0) qr[d0] = *(const bf16x8*)(Qw + (long)r32 * PITCH + d0 * 16 + hi * 8);
    asm volatile("" : "+v"(qr[0]), "+v"(qr[1]), "+v"(qr[2]), "+v"(qr[3]));
    float m = 0.f, l = 0.f;
    f32x16 o[4], negm = f32x16{};
#pragma unroll
    for (int i = 0; i < 4; ++i) o[i] = f32x16{};
    int ks_cur = 0, ks_nxt = SLOTB, ks_free = 2 * SLOTB;
    int vs_prev = 3 * SLOTB, vs_cur = 0, vs_nxt = SLOTB, vs_free = 2 * SLOTB;
    const lds_cptr kp0 = shm3 + LDS_K + c * 8192 + hi * 1024 + r32 * 16;
    const lds_cptr vp0 = shm3 + LDS_V + ((lane >> 4) & 1) * 32 + (lane & 3) * 8 + (4 * hi + ((lane & 15) >> 2)) * 64;
    const int qrel = wq * 32 + r32;
    u32x4 pw[4];
#define DA_STEP(ROLE, MASKED, t) do { \
        if ((t) + 1 < NT) { DA_WAIT_BAR(4); } else { DA_WAIT_BAR(0); }     \
        if ((t) + 2 < NT) DA_DMA_TILE((t) + 2, ks_free, vs_free); \
        f32x16 p0, p1; bf16x8 kf[8]; \
        k_frags(kf, kp0 + ks_cur); \
        if (ROLE == 0) { \
            qk_tile(p0, p1, kf, qr, negm); \
            softmax_tile<MASKED>(p0, p1, pw, o, negm, m, l, (t) == 0, 64 * ((t) - (NT - 2)) + 4 * hi, qrel, hi, r32, wsf); \
            pv_tile(o, vp0 + vs_cur, pw); \
        } else { \
            if ((t) > 0) pv_tile(o, vp0 + vs_prev, pw); \
            qk_tile(p0, p1, kf, qr, negm); \
            softmax_tile<MASKED>(p0, p1, pw, o, negm, m, l, (t) == 0, 64 * ((t) - (NT - 2)) + 4 * hi, qrel, hi, r32, wsf); \
        } \
        { const int tk = ks_cur; ks_cur = ks_nxt; ks_nxt = ks_free; ks_free = tk; const int tv = vs_prev; vs_prev = vs_cur; vs_cur = vs_nxt; vs_nxt = vs_free; vs_free = tv; } \
    } while (0)
    if (c == 0) {
        int t = 0;
        for (; t < NT - 2; ++t) DA_STEP(0, false, t);
        DA_STEP(0, true, t); ++t;
        DA_STEP(0, true, t);
    } else {
        int t = 0;
        for (; t < NT - 2; ++t) DA_STEP(1, false, t);
        DA_STEP(1, true, t); ++t;
        DA_STEP(1, true, t);
        pv_tile(o, vp0 + vs_prev, pw);
    }
#undef DA_STEP
    { auto rr = __builtin_amdgcn_permlane32_swap(__float_as_uint(l), __float_as_uint(l), false, false); l = __uint_as_float(rr[0]) + __uint_as_float(rr[1]); }
    if (hi == 0) wsf[32 + r32] = (c == 1 ? lam : 1.0f) / l;
    asm volatile("s_waitcnt lgkmcnt(0)\n\ts_barrier" ::: "memory");
    DA_LAS float* xch = (DA_LAS float*)(shm3 + LDS_XCH) + wq * 4096;
    if (c == 1) {
#pragma unroll
        for (int r = 0; r < 16; ++r) { const float rl = wsf[32 + crow(r, hi)];
#pragma unroll
            for (int db = 0; db < 4; ++db) xch[(db * 16 + r) * 64 + lane] = o[db][r] * rl; }
    }
    asm volatile("s_waitcnt lgkmcnt(0)\n\ts_barrier" ::: "memory");
    if (c == 0) {
#pragma unroll
        for (int r = 0; r < 16; ++r) { const float rl = wsf[32 + crow(r, hi)];
#pragma unroll
            for (int db = 0; db < 4; ++db) o[db][r] = o[db][r] * rl - xch[(db * 16 + r) * 64 + lane]; }
        asm volatile("s_waitcnt lgkmcnt(0)" ::: "memory");
#pragma unroll
        for (int r = 0; r < 16; ++r)
#pragma unroll
            for (int db = 0; db < 4; ++db) xch[crow(r, hi) * 128 + db * 32 + r32] = o[db][r];
        asm volatile("s_waitcnt lgkmcnt(0)" ::: "memory");
        const int dcol = 8 * (lane & 15);
        const f32x4 g0 = *(const f32x4*)(sg + dcol), g1 = *(const f32x4*)(sg + dcol + 4);
        bf16_t* Ow = MIX + (rowbase + q0 + wq * 32) * DM + h * 128 + dcol;
#pragma unroll
        for (int i = 0; i < 8; ++i) { const int row = 4 * i + (lane >> 4);
            const f32x4 v0 = *(const DA_LAS f32x4*)(xch + row * 128 + dcol), v1 = *(const DA_LAS f32x4*)(xch + row * 128 + dcol + 4);
            float ss = ((v0[0] * v0[0] + v0[1] * v0[1]) + (v0[2] * v0[2] + v0[3] * v0[3])) + ((v1[0] * v1[0] + v1[1] * v1[1]) + (v1[2] * v1[2] + v1[3] * v1[3]));
            ss += __shfl_xor(ss, 1); ss += __shfl_xor(ss, 2); ss += __shfl_xor(ss, 4); ss += __shfl_xor(ss, 8);
            const float rs = oml0 / sqrtf(ss * (1.0f / DV) + EPS);
            const f32x4 y0 = v0 * g0 * rs, y1 = v1 * g1 * rs;
            u32x4 w; w.x = cvtpk_s(y0[0], y0[1]); w.y = cvtpk_s(y0[2], y0[3]); w.z = cvtpk_s(y1[0], y1[1]); w.w = cvtpk_s(y1[2], y1[3]);
            *(u32x4*)(Ow + (long)row * DM) = w; }
    }
    asm volatile("s_waitcnt lgkmcnt(0)\n\ts_barrier" ::: "memory");
#undef DA_DMA_TILE
#undef DA_RFL
}
template <int W> __device__ __forceinline__ void pool_rows4(const bf16_t* PROJ, bf16_t* MIX, int row0, int g, int lane) {
    const int row = row0 + (lane >> 4), c8 = g * 128 + (lane & 15) * 8, t = row & (SEQ - 1);
    const bf16_t* up = PROJ + (size_t)row * INW + 3 * ATTW + c8;
    u32x4 v[W];
#pragma unroll
    for (int i = 0; i < W; ++i) v[i] = *(const u32x4*)(up - (size_t)(i <= t ? i : t) * INW);
    float s[8];
#pragma unroll
    for (int j = 0; j < 8; ++j) s[j] = 0.f;
#pragma unroll
    for (int i = 0; i < W; ++i) { const float msk = (i <= t) ? 1.0f : 0.0f;
#pragma unroll
        for (int j = 0; j < 4; ++j) { s[2 * j] = fmaf(msk, __uint_as_float(v[i][j] << 16), s[2 * j]); s[2 * j + 1] = fmaf(msk, __uint_as_float(v[i][j] & 0xffff0000u), s[2 * j + 1]); } }
    const float rn = 1.0f / (float)((t + 1 < W) ? (t + 1) : W); u32x4 o;
#pragma unroll
    for (int j = 0; j < 4; ++j) o[j] = cvtpk_s(s[2 * j] * rn - __uint_as_float(v[0][j] << 16), s[2 * j + 1] * rn - __uint_as_float(v[0][j] & 0xffff0000u));
    *(u32x4*)(MIX + (size_t)row * DM + ATTW + c8) = o;
}
__device__ __forceinline__ void attn_pool_phase(char* lds, const bf16_t* PROJ, bf16_t* MIX, const float* lam_qk, float lam0, const float* sg, int vcu, int G) {
    const int lane = threadIdx.x & 63;
    float s1 = lam_qk[lane] * lam_qk[64 + lane], s2 = lam_qk[128 + lane] * lam_qk[192 + lane];
#pragma unroll
    for (int o = 1; o < 64; o <<= 1) { s1 += __shfl_xor(s1, o); s2 += __shfl_xor(s2, o); }
    const float lam = expf(s1) - expf(s2) + lam0;
#ifndef MK_ATT_REP
#define MK_ATT_REP 1
#endif
#ifndef MK_POOL_REP
#define MK_POOL_REP 1
#endif
    for (int rep = 0; rep < MK_ATT_REP; ++rep)
    for (int v = vcu; v < BATCH * NH * 8; v += G) { const int bh = v >> 3, s = v & 7;
#pragma unroll 1
        for (int u = 0; u < 2; ++u) attn_unit(bh >> 2, bh & 3, u ? 15 - s : s, PROJ, MIX, lam, sg, 1.0f - lam0, lds); }
    for (int rep = 0; rep < MK_POOL_REP; ++rep)
    { const int wave = __builtin_amdgcn_readfirstlane((int)threadIdx.x >> 6);
      for (int it = vcu * 8 + wave; it < M; it += G * 8) { const int g = it & 3, row0 = (it >> 2) * 4;
          if (g == 0) pool_rows4<2>(PROJ, MIX, row0, 0, lane); else if (g == 1) pool_rows4<4>(PROJ, MIX, row0, 1, lane);
          else if (g == 2) pool_rows4<8>(PROJ, MIX, row0, 2, lane); else pool_rows4<16>(PROJ, MIX, row0, 3, lane); } }
}
#undef DA_WAIT_BAR
#undef DA_MFMA
}

constexpr int NWAVES = 8;
constexpr int NPHASE = 2 + 5 * DEPTH;
constexpr size_t MiB = 1u << 20;
constexpr size_t WS_CTL = 0, CTL_ZERO_BYTES = 65536;
constexpr size_t WS_W1 = 1 * MiB;
constexpr size_t WS_WO = 9 * MiB;
constexpr size_t WS_WGU = 13 * MiB;
constexpr size_t WS_WD = 35 * MiB;
constexpr size_t WS_SSQ = 46 * MiB;
constexpr size_t WS_XB = 48 * MiB;
constexpr size_t WS_PROJ = 80 * MiB;
constexpr size_t WS_MIX = 144 * MiB;
constexpr size_t WS_H = 80 * MiB;
constexpr size_t WS_END = 176 * MiB;
static_assert(WS_H + (size_t)M * DFF * 2 <= WS_END && WS_MIX + (size_t)M * DM * 2 <= WS_END && WS_SSQ + (size_t)M * NSSQ * 4 <= WS_XB, "ws map");
constexpr int CW_BAR = 1024;
constexpr int RING_OFF = 0, RING_BYTES = 131072;
constexpr int LDSCTL_OFF = RING_BYTES, MISC_OFF = LDSCTL_OFF + 320;
constexpr int LDS_BYTES = 147456;
static_assert(MISC_OFF + 128 <= LDS_BYTES && dattn::LDS_BYTES <= RING_BYTES && pg8::STAGE_BYTES <= RING_BYTES, "LDS map");

#define GAS __attribute__((address_space(1)))
#define LAS __attribute__((address_space(3)))
typedef unsigned short bf16;
typedef unsigned v4u __attribute__((ext_vector_type(4)));
typedef unsigned v2u __attribute__((ext_vector_type(2)));
typedef float f32x4 __attribute__((ext_vector_type(4)));
typedef short bf16x8 __attribute__((ext_vector_type(8)));
typedef GAS unsigned gu32;
#define RLX_AGENT __ATOMIC_RELAXED, __HIP_MEMORY_SCOPE_AGENT
#define LDS_WAIT() asm volatile("s_waitcnt lgkmcnt(0)" ::: "memory")
__device__ __forceinline__ unsigned f2bf(float f) { unsigned u = __builtin_bit_cast(unsigned, f); return (u + 0x7fffu + ((u >> 16) & 1u)) >> 16; }
__device__ __forceinline__ unsigned pk2(float lo, float hi) { return f2bf(lo) | (f2bf(hi) << 16); }
__device__ __forceinline__ float bf2f(bf16 b) { return __builtin_bit_cast(float, (unsigned)b << 16); }

#define XB_TMO      128
#define XB_XCNT(j)  (256  + 64 * (j))
#define XB_XSUB(j)  (1280 + 64 * (j))
#define XB_XGEN(j)  (2304 + 64 * (j))
#define XB_TOP      3328
#define XB_TOPGEN   3392
#define XCD_BAR_WORDS 3456
#define XB_SPIN_CAP (1u << 18)

__device__ __forceinline__ unsigned xb_ld(unsigned* p)              { return __hip_atomic_load(p, __ATOMIC_RELAXED, __HIP_MEMORY_SCOPE_AGENT); }
__device__ __forceinline__ unsigned xb_add(unsigned* p, unsigned v) { return __hip_atomic_fetch_add(p, v, __ATOMIC_RELAXED, __HIP_MEMORY_SCOPE_AGENT); }
__device__ __forceinline__ unsigned xb_xcc_id() { return (unsigned)__builtin_amdgcn_s_getreg((3 << 11) | 20) & 0xFu; }
#define XB_SPIN(cond, bar) do { unsigned _sp = 0; while (cond) { __builtin_amdgcn_s_sleep(1); \
    if ((++_sp & 255u) == 0u) { if (xb_ld(&(bar)[XB_TMO])) break; if (_sp > XB_SPIN_CAP) { atomicAdd(&(bar)[XB_TMO], 1u); break; } } } } while (0)

struct XcdBarrier {
    unsigned* bar; unsigned x;
    volatile LAS unsigned* st;
};

__device__ __forceinline__ XcdBarrier xcd_barrier_post(unsigned* bar, volatile LAS unsigned* st) {
    XcdBarrier b; b.bar = bar; b.x = xb_xcc_id(); b.st = st;
    if (threadIdx.x == 0) (void)xb_add(&bar[XB_XCNT(b.x)], 1u);
    return b;
}
__device__ __forceinline__ void xcd_barrier_complete(unsigned* bar, unsigned x, unsigned& nloc, unsigned& nx) {
    const unsigned G = gridDim.x * gridDim.y * gridDim.z;
    unsigned sum, cnt, mine, sp = 0u;
    for (;;) {
        sum = 0u; cnt = 0u; mine = 0u;
#pragma unroll
        for (unsigned j = 0; j < 16; ++j) { const unsigned c = xb_ld(&bar[XB_XCNT(j)]); sum += c; cnt += (c > 0u) ? 1u : 0u; mine = (j == x) ? c : mine; }
        if (sum == G) break;
        __builtin_amdgcn_s_sleep(1);
        if ((++sp & 255u) == 0u) { if (xb_ld(&bar[XB_TMO])) break; if (sp > XB_SPIN_CAP) { atomicAdd(&bar[XB_TMO], 1u); break; } }
    }
    nloc = mine > 0u ? mine : 1u; nx = cnt > 0u ? cnt : 1u;
}

__device__ __forceinline__ void xcd_barrier(const XcdBarrier& b) {
    asm volatile("s_waitcnt vmcnt(0)" ::: "memory");
    __syncthreads();
    if (threadIdx.x == 0) {
        unsigned* bar = b.bar;
        __builtin_amdgcn_s_waitcnt(0);
        unsigned nloc = b.st[0], nx = b.st[1];
        if (nloc == 0u) { xcd_barrier_complete(bar, b.x, nloc, nx); b.st[0] = nloc; b.st[1] = nx; }
        const unsigned old = xb_add(&bar[XB_XSUB(b.x)], 1u);
        const unsigned gen = old / nloc;
        if (old + 1u == (gen + 1u) * nloc) {
            __builtin_amdgcn_fence(__ATOMIC_RELEASE, "agent");
            asm volatile("s_waitcnt vmcnt(0)" ::: "memory");
            const unsigned og = xb_add(&bar[XB_TOP], 1u);
            const unsigned tg = og / nx;
            if (og + 1u == (tg + 1u) * nx) xb_add(&bar[XB_TOPGEN], 1u);
            else XB_SPIN(xb_ld(&bar[XB_TOPGEN]) == tg, bar);
            __builtin_amdgcn_fence(__ATOMIC_ACQUIRE, "agent");
            xb_add(&bar[XB_XGEN(b.x)], 1u);
            asm volatile("s_waitcnt vmcnt(0)" ::: "memory");
        } else {
            XB_SPIN(xb_ld(&bar[XB_XGEN(b.x)]) == gen, bar);
            __builtin_amdgcn_fence(__ATOMIC_ACQUIRE, "agent");
            asm volatile("s_waitcnt vmcnt(0)" ::: "memory");
        }
    }
    __syncthreads();
}

__device__ __forceinline__ float wave_sum(float v) {
#pragma unroll
    for (int o = 1; o < 64; o <<= 1) v += __shfl_xor(v, o);
    return v;
}
__device__ __forceinline__ void transpose_item(const float* W, int N, bf16* WT, int ldk, int k0, int n0, int rbase, const float* gain, LAS float* scr, int lane) {
    f32x4 t[8];
#pragma unroll
    for (int i = 0; i < 8; ++i) t[i] = *(const GAS f32x4*)(W + (size_t)(k0 + 8 * i + (lane >> 3)) * N + n0 + 4 * (lane & 7));
    if (gain) {
#pragma unroll
        for (int i = 0; i < 8; ++i) t[i] *= gain[k0 + 8 * i + (lane >> 3)]; }
#pragma unroll
    for (int i = 0; i < 8; ++i) { LAS float* d = scr + (8 * i + (lane >> 3)) * 33 + 4 * (lane & 7); d[0] = t[i][0]; d[1] = t[i][1]; d[2] = t[i][2]; d[3] = t[i][3]; }
    LDS_WAIT(); asm volatile("" ::: "memory");
    const int c = lane & 7;
#pragma unroll
    for (int j = 0; j < 4; ++j) { const int n = (lane >> 3) + 8 * j; const LAS float* s = scr + (8 * c) * 33 + n;
        v4u o; o.x = pk2(s[0 * 33], s[1 * 33]); o.y = pk2(s[2 * 33], s[3 * 33]); o.z = pk2(s[4 * 33], s[5 * 33]); o.w = pk2(s[6 * 33], s[7 * 33]);
        *(GAS v4u*)(WT + (size_t)(rbase + n) * ldk + k0 + 8 * c) = o; }
    LDS_WAIT(); asm volatile("" ::: "memory");
}
struct Ptrs {
    const float *x, *norm1_g, *w_in, *lam_qk, *subln_g, *pool_w, *pool_scale, *w_out, *norm2_g, *w_gate, *w_up, *w_down, *final_g;
    float* out; bf16 *W1, *WO, *WGU, *WD, *XB, *PROJ, *MIX, *H; float* SSQ;
};
__device__ __forceinline__ void p0_prologue(const Ptrs& P, LAS unsigned char* lds, int vcu, int G, int wave, int lane) {
    LAS float* scr = (LAS float*)(lds + RING_OFF + wave * 16384);
    const int gw = vcu * NWAVES + wave, NGW = G * NWAVES;
    constexpr int I_IN = (DM / 64) * (INW / 32), I_OUT = (ATTW / 64) * (DM / 32), I_G = (DM / 64) * (DFF / 32), I_D = (DFF / 64) * (DM / 32), I_LAYER = I_IN + I_OUT + 2 * I_G + I_D;
    for (int it = gw; it < DEPTH * I_LAYER; it += NGW) {
        const int l = it / I_LAYER; int r = it % I_LAYER;
        if (r < I_IN) { const int nb = INW / 32; transpose_item(P.w_in + (size_t)l * DM * INW, INW, P.W1 + (size_t)l * INW * DM, DM, 64 * (r / nb), 32 * (r % nb), 32 * (r % nb), P.norm1_g + l * DM, scr, lane); continue; } r -= I_IN;
        if (r < I_OUT) { const int nb = DM / 32; transpose_item(P.w_out + (size_t)l * DM * DM, DM, P.WO + (size_t)l * DM * DM, DM, 64 * (r / nb), 32 * (r % nb), 32 * (r % nb), nullptr, scr, lane); continue; } r -= I_OUT;
        if (r < 2 * I_G) { const int up = r >= I_G; if (up) r -= I_G; const int nb = DFF / 32, n0 = 32 * (r % nb);
            transpose_item((up ? P.w_up : P.w_gate) + (size_t)l * DM * DFF, DFF, P.WGU + (size_t)l * NGU * DM, DM, 64 * (r / nb), n0, 256 * (n0 / 128) + (n0 % 128) + 128 * up, P.norm2_g + l * DM, scr, lane); continue; } r -= 2 * I_G;
        { const int nb = DM / 32; transpose_item(P.w_down + (size_t)l * DFF * DM, DM, P.WD + (size_t)l * DM * DFF, DFF, 64 * (r / nb), 32 * (r % nb), 32 * (r % nb), nullptr, scr, lane); }
    }
    for (int it = gw; it < DEPTH * 4 * 16 * 16; it += NGW) {
        const int l = it >> 10, g = (it >> 8) & 3, c0 = ((it >> 4) & 15) * 8, n = (it & 15) * 64 + lane;
        typedef const __attribute__((address_space(4))) float* cfp;
        cfp pw = (cfp)(P.pool_w + (size_t)l * 4 * 128 * 128 + ((size_t)g * 128 + c0) * 128); cfp sc = (cfp)(P.pool_scale + l * 512 + 128 * g);
        const GAS float* wo = (const GAS float*)(P.w_out + (size_t)l * DM * DM + (size_t)(512 + 128 * g) * DM + n);
        float acc[8];
#pragma unroll
        for (int j = 0; j < 8; ++j) acc[j] = 0.f;
#pragma unroll 16
        for (int d = 0; d < 128; ++d) { const float w = wo[(size_t)d * DM] * sc[d];
#pragma unroll
            for (int j = 0; j < 8; ++j) acc[j] = fmaf(pw[j * 128 + d], w, acc[j]); }
        v4u o; o.x = pk2(acc[0], acc[1]); o.y = pk2(acc[2], acc[3]); o.z = pk2(acc[4], acc[5]); o.w = pk2(acc[6], acc[7]);
        *(GAS v4u*)(P.WO + (size_t)l * DM * DM + (size_t)n * DM + 512 + 128 * g + c0) = o;
    }
    for (int row = gw; row < M; row += NGW) {
        const GAS f32x4* xr = (const GAS f32x4*)(P.x + (size_t)row * DM) + lane; float s = 0.f;
#pragma unroll
        for (int j = 0; j < 4; ++j) { const f32x4 v = xr[64 * j]; s += (v.x * v.x + v.y * v.y) + (v.z * v.z + v.w * v.w);
            v2u o; o.x = pk2(v.x, v.y); o.y = pk2(v.z, v.w); *((GAS v2u*)(P.XB + (size_t)row * DM) + lane + 64 * j) = o; }
        s = wave_sum(s);
        if (lane < 4) *((GAS f32x4*)(P.SSQ + (size_t)row * NSSQ) + lane) = (f32x4){lane == 0 ? s : 0.f, 0.f, 0.f, 0.f};
    }
}
__device__ __forceinline__ void final_norm(float* outp, const float* fg, int vcu, int G, int wave, int lane) {
    const int gw = vcu * NWAVES + wave, NGW = G * NWAVES;
    for (int row = gw; row < M; row += NGW) {
        GAS f32x4* xr = (GAS f32x4*)(outp + (size_t)row * DM) + lane; const GAS f32x4* gr = (const GAS f32x4*)fg + lane;
        f32x4 v[4]; float s = 0.f;
#pragma unroll
        for (int j = 0; j < 4; ++j) { v[j] = xr[64 * j]; s += (v[j].x * v[j].x + v[j].y * v[j].y) + (v[j].z * v[j].z + v[j].w * v[j].w); }
        const float r = 1.0f / sqrtf(wave_sum(s) * (1.0f / DM) + EPS);
#pragma unroll
        for (int j = 0; j < 4; ++j) xr[64 * j] = v[j] * r * gr[64 * j];
    }
}

struct Args { const float* in[13]; float* out; unsigned char* ws; int ph_lo, ph_hi; };
typedef const __attribute__((address_space(4))) Args* kargs_t;
#define KARGS(A_) kargs_t A_ = (kargs_t)__builtin_amdgcn_kernarg_segment_ptr(); asm volatile("" : "+s"(A_))
__device__ __forceinline__ void fill_ptrs(Ptrs& P, kargs_t A) {
    unsigned char* ws = A->ws;
    P.x = A->in[0]; P.norm1_g = A->in[1]; P.w_in = A->in[2]; P.lam_qk = A->in[3]; P.subln_g = A->in[4]; P.pool_w = A->in[5]; P.pool_scale = A->in[6]; P.w_out = A->in[7];
    P.norm2_g = A->in[8]; P.w_gate = A->in[9]; P.w_up = A->in[10]; P.w_down = A->in[11]; P.final_g = A->in[12]; P.out = A->out;
    P.W1 = (bf16*)(ws + WS_W1); P.WO = (bf16*)(ws + WS_WO); P.WGU = (bf16*)(ws + WS_WGU); P.WD = (bf16*)(ws + WS_WD); P.XB = (bf16*)(ws + WS_XB);
    P.PROJ = (bf16*)(ws + WS_PROJ); P.MIX = (bf16*)(ws + WS_MIX); P.H = (bf16*)(ws + WS_H); P.SSQ = (float*)(ws + WS_SSQ);
}
__global__ void __launch_bounds__(NWAVES * 64, 2) mk_fwd(Args args) {
    extern __shared__ __attribute__((aligned(16))) unsigned char lds_raw[];
    LAS unsigned char* lds = (LAS unsigned char*)lds_raw;
    volatile LAS unsigned* MISC = (volatile LAS unsigned*)(lds + MISC_OFF);
    const int tid = threadIdx.x, lane = tid & 63, wave = __builtin_amdgcn_readfirstlane(tid >> 6);
    const int G = gridDim.x; const int bx = blockIdx.x; const int vcu = (G % 8 == 0) ? (bx % 8) * (G / 8) + bx / 8 : bx;
    for (int u = tid; u < (LDS_BYTES - LDSCTL_OFF) / 4; u += NWAVES * 64) ((LAS unsigned*)(lds + LDSCTL_OFF))[u] = 0u;
    __syncthreads();
    const int lo = args.ph_lo, hi = args.ph_hi;
    XcdBarrier bar; bar.bar = (unsigned*)(args.ws + WS_CTL) + CW_BAR; bar.x = 0; bar.st = nullptr;
    if (hi - lo > 1) bar = xcd_barrier_post((unsigned*)(args.ws + WS_CTL) + CW_BAR, MISC + 8);
#ifndef MK_EN
#define MK_EN 0xffu
#endif
#define IN(k) (lo <= (k) && (k) < hi)
#ifndef MK_BAR_REP
#define MK_BAR_REP 1
#endif
#define SEAM(k) do { if (IN(k) && IN((k) + 1)) { for (int rep_ = 0; rep_ < MK_BAR_REP; ++rep_) xcd_barrier(bar); } } while (0)

    if (IN(0) && (MK_EN & 1u)) { KARGS(A); Ptrs P; fill_ptrs(P, A); p0_prologue(P, lds, vcu, G, wave, lane); SEAM(0); }

    for (int l = 0; l < DEPTH; ++l) {
        const int pb = 1 + 5 * l;
        if (IN(pb) && (MK_EN & 2u)) {
            KARGS(A); unsigned char* ws = A->ws;
            pg8::Gemm g{(const bf16*)(ws + WS_XB), (const bf16*)(ws + WS_W1) + (size_t)l * INW * DM, M, INW, DM}; pg8::StaticOrder S; S.init(M, INW, G, bx);
            pg8::EpiProj E{(bf16*)(ws + WS_PROJ), (const float*)(ws + WS_SSQ)};
            pg8::gemm_phase<pg8::EpiProj, pg8::StaticOrder, true, true>(lds + RING_OFF, g, S, E);
            SEAM(pb);
        }
        if (IN(pb + 1) && (MK_EN & 4u)) {
            KARGS(A); unsigned char* ws = A->ws;
            dattn::attn_pool_phase((char*)lds_raw + RING_OFF, (const bf16*)(ws + WS_PROJ), (bf16*)(ws + WS_MIX), A->in[3] + l * 256, l == 0 ? LAM0_0 : LAM0_1, A->in[4] + l * DV, vcu, G);
            SEAM(pb + 1);
        }
        if (IN(pb + 2) && (MK_EN & 8u)) {
            KARGS(A); unsigned char* ws = A->ws;
            pg8::Gemm g{(const bf16*)(ws + WS_MIX), (const bf16*)(ws + WS_WO) + (size_t)l * DM * DM, M, DM, DM}; pg8::StaticOrder S; S.init(M, DM, G, bx);
            pg8::EpiRes E{l == 0 ? A->in[0] : nullptr, (bf16*)(ws + WS_XB), nullptr, (float*)(ws + WS_SSQ)};
            pg8::gemm_phase<pg8::EpiRes, pg8::StaticOrder, true, true>(lds + RING_OFF, g, S, E);
            SEAM(pb + 2);
        }
        if (IN(pb + 3) && (MK_EN & 16u)) {
            KARGS(A); unsigned char* ws = A->ws;
            pg8::Gemm g{(const bf16*)(ws + WS_XB), (const bf16*)(ws + WS_WGU) + (size_t)l * NGU * DM, M, NGU, DM}; pg8::StaticOrder S; S.init(M, NGU, G, bx);
            pg8::EpiSwiglu E{(bf16*)(ws + WS_H), (const float*)(ws + WS_SSQ)};
            pg8::gemm_phase<pg8::EpiSwiglu, pg8::StaticOrder, true, true>(lds + RING_OFF, g, S, E);
            SEAM(pb + 3);
        }
        if (IN(pb + 4) && (MK_EN & 32u)) {
            KARGS(A); unsigned char* ws = A->ws; float* out = A->out;
            pg8::Gemm g{(const bf16*)(ws + WS_H), (const bf16*)(ws + WS_WD) + (size_t)l * DM * DFF, M, DM, DFF}; pg8::StaticOrder S; S.init(M, DM, G, bx);
            pg8::EpiRes E{nullptr, (bf16*)(ws + WS_XB), (l + 1 < DEPTH) ? nullptr : out, (float*)(ws + WS_SSQ)};
            pg8::gemm_phase<pg8::EpiRes, pg8::StaticOrder, true, true>(lds + RING_OFF, g, S, E);
            SEAM(pb + 4);
        }
    }
    if (IN(NPHASE - 1) && (MK_EN & 64u)) { KARGS(A); final_norm(A->out, A->in[12], vcu, G, wave, lane); }
#undef IN
#undef SEAM
}

#ifndef MK_ONE_LAUNCH
#define MK_ONE_LAUNCH 1
#endif
#ifndef MK_NAIVE_MASK
#define MK_NAIVE_MASK 0u
#endif
#if !MK_ONE_LAUNCH
constexpr size_t WS_LAM = 47 * MiB;
__global__ void __launch_bounds__(256) k_transpose(const float* __restrict__ W, int K, int N, bf16* __restrict__ WT, int ldk, int row_off, int mode) {
    __shared__ float scr_all[4][64 * 33];
    const int wave = threadIdx.x >> 6, lane = threadIdx.x & 63;
    float* scr = scr_all[wave];
    const int nblk = N / 32, nitems = (K / 64) * nblk;
    for (int item = blockIdx.x * 4 + wave; item < nitems; item += gridDim.x * 4) {
        const int kb = item / nblk, nb = item % nblk, k0 = 64 * kb, n0 = 32 * nb;
        for (int i = 0; i < 32; ++i) { const int kk = 2 * i + (lane >> 5); scr[kk * 33 + (lane & 31)] = W[(size_t)(k0 + kk) * N + n0 + (lane & 31)]; }
        __builtin_amdgcn_wave_barrier(); asm volatile("s_waitcnt lgkmcnt(0)" ::: "memory");
        const int c = lane & 7;
        const int rbase = (mode == 1) ? (256 * (n0 / 128) + (n0 % 128) + row_off) : (row_off + n0);
        for (int j = 0; j < 4; ++j) { const int n = (lane >> 3) + 8 * j; const float* s = scr + (8 * c) * 33 + n;
            uint4 o; o.x = pk2(s[0 * 33], s[1 * 33]); o.y = pk2(s[2 * 33], s[3 * 33]); o.z = pk2(s[4 * 33], s[5 * 33]); o.w = pk2(s[6 * 33], s[7 * 33]);
            *(uint4*)(WT + (size_t)(rbase + n) * ldk + k0 + 8 * c) = o; }
        asm volatile("s_waitcnt lgkmcnt(0)" ::: "memory"); __builtin_amdgcn_wave_barrier();
    }
}
__global__ void __launch_bounds__(256) k_fold_pool(const float* __restrict__ pool_w, const float* __restrict__ scale, const float* __restrict__ w_out, bf16* __restrict__ WoT) {
    const int idx = blockIdx.x * 256 + threadIdx.x;
    const int n = idx & 1023, gc = idx >> 10, g = gc >> 7, c = gc & 127;
    const float* pw = pool_w + ((size_t)g * 128 + c) * 128; const float* sc = scale + 128 * g; const float* wo = w_out + (size_t)(512 + 128 * g) * DM + n;
    float acc = 0.f;
    for (int d = 0; d < 128; ++d) acc = fmaf(pw[d] * sc[d], wo[(size_t)d * DM], acc);
    WoT[(size_t)n * DM + 512 + gc] = (bf16)f2bf(acc);
}
__global__ void k_lambda(const float* __restrict__ lam_qk, float* __restrict__ lam_out) {
    const int l = threadIdx.x; if (l >= DEPTH) return;
    const float* q = lam_qk + l * 256; float s1 = 0.f, s2 = 0.f;
    for (int i = 0; i < 64; ++i) { s1 += q[i] * q[64 + i]; s2 += q[128 + i] * q[192 + i]; }
    lam_out[l] = expf(s1) - expf(s2) + (l == 0 ? LAM0_0 : LAM0_1);
}
__global__ void __launch_bounds__(256) k_prep_x(const float* __restrict__ x, const float* __restrict__ g, bf16* __restrict__ XB, float* __restrict__ SSQ) {
    const int row = blockIdx.x * 4 + (threadIdx.x >> 6), lane = threadIdx.x & 63;
    const f32x4* xr = (const f32x4*)(x + (size_t)row * DM) + lane; const f32x4* gr = (const f32x4*)g + lane;
    float s = 0.f;
    for (int j = 0; j < 4; ++j) { const f32x4 v = xr[64 * j], gg = gr[64 * j]; s += (v.x * v.x + v.y * v.y) + (v.z * v.z + v.w * v.w);
        uint2 o; o.x = pk2(v.x * gg.x, v.y * gg.y); o.y = pk2(v.z * gg.z, v.w * gg.w); *((uint2*)(XB + (size_t)row * DM) + lane + 64 * j) = o; }
    for (int o = 1; o < 64; o <<= 1) s += __shfl_xor(s, o);
    if (lane < 4) *((f32x4*)(SSQ + (size_t)row * NSSQ) + lane) = (f32x4){lane == 0 ? s : 0.f, 0.f, 0.f, 0.f};
}
enum { EPI_PROJ = 0, EPI_RES = 1, EPI_SWIGLU = 2 };
struct EpiArgs { bf16* outb; float* outf; const float* base; const float* SSQ; int ldc; int pad; };
template <int EPI, int NB> __global__ void __launch_bounds__(256) k_gemm(const bf16* __restrict__ A, const bf16* __restrict__ Bt, int K, EpiArgs e) {
    const int lane = threadIdx.x & 63, w = threadIdx.x >> 6, fr = lane & 15, fq = lane >> 4;
    const int m0 = blockIdx.y * 128 + 64 * (w >> 1), n0 = blockIdx.x * (NB * 128) + 64 * (w & 1);
    f32x4 acc[NB][4][4];
    for (int g = 0; g < NB; ++g) for (int i = 0; i < 4; ++i) for (int j = 0; j < 4; ++j) acc[g][i][j] = (f32x4){0.f, 0.f, 0.f, 0.f};
    const bf16* ap = A + (size_t)(m0 + fr) * K + 8 * fq; const bf16* bp = Bt + (size_t)(n0 + fr) * K + 8 * fq;
    for (int k0 = 0; k0 < K; k0 += 32) {
        bf16x8 af[4], bfr[NB][4];
#pragma unroll
        for (int i = 0; i < 4; ++i) af[i] = *(const bf16x8*)(ap + (size_t)(16 * i) * K + k0);
#pragma unroll
        for (int g = 0; g < NB; ++g)
#pragma unroll
            for (int j = 0; j < 4; ++j) bfr[g][j] = *(const bf16x8*)(bp + (size_t)(128 * g + 16 * j) * K + k0);
#pragma unroll
        for (int g = 0; g < NB; ++g)
#pragma unroll
            for (int i = 0; i < 4; ++i)
#pragma unroll
                for (int j = 0; j < 4; ++j) acc[g][i][j] = __builtin_amdgcn_mfma_f32_16x16x32_bf16(bfr[g][j], af[i], acc[g][i][j], 0, 0, 0);
    }
#pragma unroll
    for (int i = 0; i < 4; ++i) {
        const int row = m0 + 16 * i + fr;
        if (EPI == EPI_PROJ) {
            const float r = pg8::rstd16(e.SSQ, row);
#pragma unroll
            for (int j = 0; j < 4; ++j) { const int col = n0 + 16 * j + 4 * fq; const float s = (col < ATTW) ? r * C2 : r; const f32x4 v = acc[0][i][j] * s;
                uint2 o; o.x = pk2(v.x, v.y); o.y = pk2(v.z, v.w); *(uint2*)(e.outb + (size_t)row * e.ldc + col) = o; }
        } else if (EPI == EPI_RES) {
#pragma unroll
            for (int j = 0; j < 4; ++j) { const int col = n0 + 16 * j + 4 * fq; const f32x4 b = *(const f32x4*)(e.base + (size_t)row * e.ldc + col);
                *(f32x4*)(e.outf + (size_t)row * e.ldc + col) = b + acc[0][i][j]; }
        } else {
            const float r = pg8::rstd16(e.SSQ, row);
#pragma unroll
            for (int j = 0; j < 4; ++j) { const int col = blockIdx.x * 128 + 64 * (w & 1) + 16 * j + 4 * fq;
                const f32x4 gt = acc[0][i][j] * r, up = acc[NB - 1][i][j] * r; f32x4 h;
                for (int q = 0; q < 4; ++q) h[q] = gt[q] / (1.0f + __expf(-gt[q])) * up[q];
                uint2 o; o.x = pk2(h.x, h.y); o.y = pk2(h.z, h.w); *(uint2*)(e.outb + (size_t)row * e.ldc + col) = o; }
        }
    }
}
__global__ void __launch_bounds__(128) k_attn_naive(const bf16* __restrict__ PROJ, bf16* __restrict__ MIX, const float* __restrict__ lamp, int layer, const float* __restrict__ subln_g, float one_minus_lam0) {
    __shared__ float s1[SEQ], s2[SEQ], qv[128], red[8];
    const int tid = threadIdx.x, qpos = blockIdx.x, h = blockIdx.y, b = blockIdx.z;
    const size_t row = (size_t)b * SEQ + qpos;
    qv[tid] = bf2f(PROJ[row * INW + h * 128 + tid]);
    __syncthreads();
    float m1 = -INFINITY, m2 = -INFINITY;
    for (int j = tid; j <= qpos; j += 128) {
        const bf16* kr = PROJ + ((size_t)b * SEQ + j) * INW + ATTW + h * 128; float a1 = 0.f, a2 = 0.f;
        for (int d = 0; d < 64; ++d) { a1 += qv[d] * bf2f(kr[d]); a2 += qv[64 + d] * bf2f(kr[64 + d]); }
        s1[j] = a1; s2[j] = a2; m1 = fmaxf(m1, a1); m2 = fmaxf(m2, a2);
    }
    for (int o = 1; o < 64; o <<= 1) { m1 = fmaxf(m1, __shfl_xor(m1, o)); m2 = fmaxf(m2, __shfl_xor(m2, o)); }
    if ((tid & 63) == 0) { red[tid >> 6] = m1; red[2 + (tid >> 6)] = m2; }
    __syncthreads();
    m1 = fmaxf(red[0], red[1]); m2 = fmaxf(red[2], red[3]);
    float l1 = 0.f, l2 = 0.f;
    for (int j = tid; j <= qpos; j += 128) { const float p1 = exp2f(s1[j] - m1), p2 = exp2f(s2[j] - m2); s1[j] = p1; s2[j] = p2; l1 += p1; l2 += p2; }
    for (int o = 1; o < 64; o <<= 1) { l1 += __shfl_xor(l1, o); l2 += __shfl_xor(l2, o); }
    if ((tid & 63) == 0) { red[4 + (tid >> 6)] = l1; red[6 + (tid >> 6)] = l2; }
    __syncthreads();
    l1 = red[4] + red[5]; l2 = red[6] + red[7];
    float o1 = 0.f, o2 = 0.f;
    const bf16* vp = PROJ + (size_t)b * SEQ * INW + 2 * ATTW + h * 128 + tid;
    for (int j = 0; j <= qpos; ++j) { const float v = bf2f(vp[(size_t)j * INW]); o1 = fmaf(s1[j], v, o1); o2 = fmaf(s2[j], v, o2); }
    const float lam = lamp[layer];
    const float a = o1 / l1 - lam * (o2 / l2);
    float ss = a * a;
    for (int o = 1; o < 64; o <<= 1) ss += __shfl_xor(ss, o);
    __syncthreads();
    if ((tid & 63) == 0) red[tid >> 6] = ss;
    __syncthreads();
    ss = red[0] + red[1];
    const float y = a * (1.0f / sqrtf(ss * (1.0f / DV) + EPS)) * subln_g[tid] * one_minus_lam0;
    MIX[row * DM + h * 128 + tid] = (bf16)f2bf(y);
}
__global__ void __launch_bounds__(256) k_pool_naive(const bf16* __restrict__ PROJ, bf16* __restrict__ MIX) {
    const int idx = blockIdx.x * 256 + threadIdx.x, c = idx & 511, row = idx >> 9, t = row & (SEQ - 1), g = c >> 7, w = 2 << g;
    const int n = (t + 1 < w) ? (t + 1) : w;
    const bf16* up = PROJ + (size_t)row * INW + 3 * ATTW + c; float s = 0.f;
    for (int i = 0; i < n; ++i) s += bf2f(*(up - (size_t)i * INW));
    MIX[(size_t)row * DM + ATTW + c] = (bf16)f2bf(s / (float)n - bf2f(*up));
}
__global__ void __launch_bounds__(256) k_final(float* __restrict__ x, const float* __restrict__ g) {
    const int row = blockIdx.x * 4 + (threadIdx.x >> 6), lane = threadIdx.x & 63;
    f32x4* xr = (f32x4*)(x + (size_t)row * DM) + lane; const f32x4* gr = (const f32x4*)g + lane;
    f32x4 v[4]; float s = 0.f;
    for (int j = 0; j < 4; ++j) { v[j] = xr[64 * j]; s += (v[j].x * v[j].x + v[j].y * v[j].y) + (v[j].z * v[j].z + v[j].w * v[j].w); }
    for (int o = 1; o < 64; o <<= 1) s += __shfl_xor(s, o);
    const float r = 1.0f / sqrtf(s * (1.0f / DM) + EPS);
    for (int j = 0; j < 4; ++j) xr[64 * j] = v[j] * r * gr[64 * j];
}
static void naive_phase(int p, const Ptrs& P, unsigned char* ws, hipStream_t stream) {
    float* LAM = (float*)(ws + WS_LAM);
    if (p == 0) {
        for (int l = 0; l < DEPTH; ++l) {
            k_transpose<<<512, 256, 0, stream>>>(P.w_in + (size_t)l * DM * INW, DM, INW, P.W1 + (size_t)l * INW * DM, DM, 0, 0);
            k_transpose<<<512, 256, 0, stream>>>(P.w_out + (size_t)l * DM * DM, ATTW, DM, P.WO + (size_t)l * DM * DM, DM, 0, 0);
            k_transpose<<<512, 256, 0, stream>>>(P.w_gate + (size_t)l * DM * DFF, DM, DFF, P.WGU + (size_t)l * NGU * DM, DM, 0, 1);
            k_transpose<<<512, 256, 0, stream>>>(P.w_up + (size_t)l * DM * DFF, DM, DFF, P.WGU + (size_t)l * NGU * DM, DM, 128, 1);
            k_transpose<<<512, 256, 0, stream>>>(P.w_down + (size_t)l * DFF * DM, DFF, DM, P.WD + (size_t)l * DM * DFF, DFF, 0, 0);
            k_fold_pool<<<512 * 1024 / 256, 256, 0, stream>>>(P.pool_w + (size_t)l * 4 * 128 * 128, P.pool_scale + l * 512, P.w_out + (size_t)l * DM * DM, P.WO + (size_t)l * DM * DM);
        }
        k_prep_x<<<M / 4, 256, 0, stream>>>(P.x, P.norm1_g, P.XB, P.SSQ);
        return;
    }
    if (p == NPHASE - 1) { k_final<<<M / 4, 256, 0, stream>>>(P.out, P.final_g); return; }
    const int l = (p - 1) / 5, k = (p - 1) % 5;
    if (k == 0) { EpiArgs e{P.PROJ, nullptr, nullptr, P.SSQ, INW, 0}; k_gemm<EPI_PROJ, 1><<<dim3(INW / 128, M / 128), 256, 0, stream>>>(P.XB, P.W1 + (size_t)l * INW * DM, DM, e); }
    if (k == 1) { k_lambda<<<1, 64, 0, stream>>>(P.lam_qk, LAM);
        k_attn_naive<<<dim3(SEQ, NH, BATCH), 128, 0, stream>>>(P.PROJ, P.MIX, LAM, l, P.subln_g + l * DV, 1.0f - (l == 0 ? LAM0_0 : LAM0_1));
        k_pool_naive<<<M * 512 / 256, 256, 0, stream>>>(P.PROJ, P.MIX); }
    if (k == 2) { EpiArgs e{nullptr, P.out, l == 0 ? P.x : P.out, nullptr, DM, 0}; k_gemm<EPI_RES, 1><<<dim3(DM / 128, M / 128), 256, 0, stream>>>(P.MIX, P.WO + (size_t)l * DM * DM, DM, e);
        k_prep_x<<<M / 4, 256, 0, stream>>>(P.out, P.norm2_g + l * DM, P.XB, P.SSQ); }
    if (k == 3) { EpiArgs e{P.H, nullptr, nullptr, P.SSQ, DFF, 0}; k_gemm<EPI_SWIGLU, 2><<<dim3(DFF / 128, M / 128), 256, 0, stream>>>(P.XB, P.WGU + (size_t)l * NGU * DM, DM, e); }
    if (k == 4) { EpiArgs e{nullptr, P.out, P.out, nullptr, DM, 0}; k_gemm<EPI_RES, 1><<<dim3(DM / 128, M / 128), 256, 0, stream>>>(P.H, P.WD + (size_t)l * DM * DFF, DFF, e);
        if (l + 1 < DEPTH) k_prep_x<<<M / 4, 256, 0, stream>>>(P.out, P.norm1_g + (l + 1) * DM, P.XB, P.SSQ); }
}
#endif

extern "C" void kernel_launch(void* const* d_in, const int* in_sizes, int n_in, void* d_out, int out_size, void* d_ws, size_t ws_size, hipStream_t stream) {
    static int grid = 0;
    if (grid == 0) {
        if (n_in != 13 || in_sizes[0] != M * DM || out_size != M * DM || ws_size < WS_END) { fprintf(stderr, "kernel_launch: unexpected shapes (n_in %d, ws %zu); nothing launched\n", n_in, ws_size); grid = -1; return; }
        int dev = 0, cus = 0, per_cu = 0;
        if (hipGetDevice(&dev) != hipSuccess || hipDeviceGetAttribute(&cus, hipDeviceAttributeMultiprocessorCount, dev) != hipSuccess) { fprintf(stderr, "kernel_launch: device query failed\n"); grid = -1; return; }
        if (hipFuncSetAttribute((const void*)mk_fwd, hipFuncAttributeMaxDynamicSharedMemorySize, LDS_BYTES) != hipSuccess) { fprintf(stderr, "kernel_launch: hipFuncSetAttribute failed\n"); grid = -1; return; }
        if (hipOccupancyMaxActiveBlocksPerMultiprocessor(&per_cu, (const void*)mk_fwd, NWAVES * 64, LDS_BYTES) != hipSuccess || per_cu < 1)
            fprintf(stderr, "kernel_launch: note: occupancy query reports %d workgroups per CU\n", per_cu);
        (void)hipGetLastError();
        grid = cus;
    }
    if (grid < 0) return;
    if (hipMemsetAsync((char*)d_ws + WS_CTL, 0, CTL_ZERO_BYTES, stream) != hipSuccess) { fprintf(stderr, "kernel_launch: hipMemsetAsync failed\n"); return; }
    Args a{};
    for (int i = 0; i < 13; ++i) a.in[i] = (const float*)d_in[i];
    a.out = (float*)d_out; a.ws = (unsigned char*)d_ws;
#if MK_ONE_LAUNCH
    a.ph_lo = 0; a.ph_hi = NPHASE;
    hipLaunchKernelGGL(mk_fwd, dim3(grid), dim3(NWAVES * 64), LDS_BYTES, stream, a);
#else
    unsigned char* ws = (unsigned char*)d_ws;
    Ptrs P;
    P.x = a.in[0]; P.norm1_g = a.in[1]; P.w_in = a.in[2]; P.lam_qk = a.in[3]; P.subln_g = a.in[4]; P.pool_w = a.in[5]; P.pool_scale = a.in[6]; P.w_out = a.in[7];
    P.norm2_g = a.in[8]; P.w_gate = a.in[9]; P.w_up = a.in[10]; P.w_down = a.in[11]; P.final_g = a.in[12]; P.out = a.out;
    P.W1 = (bf16*)(ws + WS_W1); P.WO = (bf16*)(ws + WS_WO); P.WGU = (bf16*)(ws + WS_WGU); P.WD = (bf16*)(ws + WS_WD); P.XB = (bf16*)(ws + WS_XB);
    P.PROJ = (bf16*)(ws + WS_PROJ); P.MIX = (bf16*)(ws + WS_MIX); P.H = (bf16*)(ws + WS_H); P.SSQ = (float*)(ws + WS_SSQ);
    for (int p = 0; p < NPHASE; ++p) {
        if ((MK_NAIVE_MASK >> p) & 1u) { naive_phase(p, P, ws, stream); continue; }
        a.ph_lo = p; a.ph_hi = p + 1;
        hipLaunchKernelGGL(mk_fwd, dim3(grid), dim3(NWAVES * 64), LDS_BYTES, stream, a);
#ifdef MK_DUP_MASK
        if ((MK_DUP_MASK >> p) & 1u) hipLaunchKernelGGL(mk_fwd, dim3(grid), dim3(NWAVES * 64), LDS_BYTES, stream, a);
#endif
    }
#endif
    const hipError_t le = hipPeekAtLastError();
    if (le != hipSuccess) fprintf(stderr, "kernel_launch: launch failed: %s (grid %d)\n", hipGetErrorName(le), grid);
}
```
